# Optimizing an MI355X kernel written in HIP

```python
import jax, jax.numpy as jnp
from jax import lax
import numpy as np

D_MODEL = 2048
BATCH = 4
SEQ = 2048
DEPTH = 1
DEC_BATCH = 8
DEC_SEQ = 1
PAST_LEN = 16384
PAGE_SIZE = 128

D_MIX = D_MODEL
D_RET = D_MIX // 2
D_ATT = D_MIX - D_RET
HEAD_DIM = 128
N_RET_HEADS = D_RET // HEAD_DIM
N_ATT_HEADS = D_ATT // HEAD_DIM
N_KV_HEADS = 2
N_GROUP = N_ATT_HEADS // N_KV_HEADS
D_KV = N_KV_HEADS * HEAD_DIM
N_IDX_HEADS = 16
D_IDX = 128
TOPK_MAX = 256
RET_CHUNK = 128
Q_BLOCK = 128
ROPE_BASE = 10000.0
NORM_EPS = 1e-6
SPLITS = (D_RET, D_RET, D_RET, D_RET, D_ATT, D_KV, D_KV, D_ATT, N_IDX_HEADS * D_IDX, D_IDX, N_IDX_HEADS)
D_IN_PROJ = 4 * D_RET + 2 * D_ATT + 2 * D_KV + N_IDX_HEADS * D_IDX + D_IDX + N_IDX_HEADS

kernel_name = "hymba_retention_dsa_step"


def rmsnorm(x, g):
    xf = x.astype(jnp.float32)
    y = xf * lax.rsqrt(jnp.mean(xf * xf, -1, keepdims=True) + NORM_EPS)
    return (y * g.astype(jnp.float32)).astype(x.dtype)


def head_group_norm(o, g):
    of = o.astype(jnp.float32)
    mu = jnp.mean(of, -1, keepdims=True)
    var = jnp.mean(jnp.square(of - mu), -1, keepdims=True)
    return ((of - mu) * lax.rsqrt(var + NORM_EPS) * g.astype(jnp.float32)).astype(o.dtype)


def rotary(x, pos):
    half = x.shape[-1] // 2
    inv = ROPE_BASE ** (-jnp.arange(half, dtype=jnp.float32) / half)
    ang = pos.astype(jnp.float32)[:, None] * inv[None, :]
    cos = jnp.cos(ang)[None, :, None, :].astype(x.dtype)
    sin = jnp.sin(ang)[None, :, None, :].astype(x.dtype)
    x1, x2 = x[..., :half], x[..., half:]
    return jnp.concatenate([x1 * cos - x2 * sin, x1 * sin + x2 * cos], -1)


def retention_log_decay():
    return jnp.log1p(-jnp.exp2(-5.0 - jnp.arange(N_RET_HEADS, dtype=jnp.float32)))


def retention_chunk(q, k, v, s_prev, log_g):
    c = q.shape[1]
    i = jnp.arange(c, dtype=jnp.float32)
    diff = i[:, None] - i[None, :]
    decay = jnp.where(diff[None] >= 0, jnp.exp(jnp.maximum(diff, 0.0)[None] * log_g[:, None, None]), 0.0).astype(q.dtype)
    scores = jnp.einsum('bihd,bjhd->bhij', q, k) * decay[None]
    inner = jnp.einsum('bhij,bjhe->bihe', scores, v)
    q_dec = jnp.exp((i[:, None] + 1.0) * log_g[None, :]).astype(q.dtype)
    cross = jnp.einsum('bihd,bhde->bihe', q, s_prev.astype(q.dtype)) * q_dec[None, :, :, None]
    k_dec = jnp.exp((c - 1.0 - i)[:, None] * log_g[None, :]).astype(k.dtype)
    s_new = jnp.exp(c * log_g).astype(s_prev.dtype)[None, :, None, None] * s_prev + jnp.einsum('bjhd,bjhe->bhde', k * k_dec[None, :, :, None], v)
    return inner + cross, s_new.astype(s_prev.dtype)


def retention_prompt(q, k, v, log_g):
    b, t, h, d = q.shape
    c = min(RET_CHUNK, t)
    nc = t // c
    def chunks(a):
        return jnp.moveaxis(a.reshape((b, nc, c) + a.shape[2:]), 1, 0)
    s0 = jnp.zeros((b, h, d, v.shape[-1]), dtype=v.dtype)
    def step(s, qkv):
        o, s = retention_chunk(qkv[0], qkv[1], qkv[2], s, log_g)
        return s, o
    s_fin, outs = lax.scan(step, s0, (chunks(q), chunks(k), chunks(v)))
    return jnp.moveaxis(outs, 0, 1).reshape(b, t, h, v.shape[-1]), s_fin


def project(x, g_norm, w_in, pos):
    b, t = x.shape[:2]
    z = rmsnorm(x, g_norm) @ w_in
    offs = [int(o) for o in np.cumsum(SPLITS)[:-1]]
    q_r, k_r, v_r, g_r, q_a, k_a, v_a, g_a, q_i, k_i, w_i = jnp.split(z, offs, axis=-1)
    q_r = rotary(q_r.reshape(b, t, N_RET_HEADS, HEAD_DIM), pos)
    k_r = rotary(k_r.reshape(b, t, N_RET_HEADS, HEAD_DIM), pos) * (HEAD_DIM ** -0.5)
    v_r = v_r.reshape(b, t, N_RET_HEADS, HEAD_DIM)
    q_a = q_a.reshape(b, t, N_KV_HEADS, N_GROUP, HEAD_DIM)
    k_a = k_a.reshape(b, t, N_KV_HEADS, HEAD_DIM)
    v_a = v_a.reshape(b, t, N_KV_HEADS, HEAD_DIM)
    q_i = q_i.reshape(b, t, N_IDX_HEADS, D_IDX)
    w_i = w_i * (N_IDX_HEADS ** -0.5 * D_IDX ** -0.5)
    return q_r, k_r, v_r, g_r, q_a, k_a, v_a, g_a, q_i, k_i, w_i


def indexer_select(q_i, w_i, k_i_all, q_pos, n_sel):
    rel = jax.nn.relu(jnp.einsum('bqhd,bsd->bqhs', q_i, k_i_all))
    score = jnp.einsum('bqh,bqhs->bqs', w_i, rel).astype(jnp.float32)
    key_pos = jnp.arange(k_i_all.shape[1], dtype=jnp.int32)
    score = jnp.where(key_pos[None, None, :] <= q_pos[None, :, None], score, -jnp.inf)
    _, idx = lax.top_k(score, n_sel)
    valid = idx <= q_pos[None, :, None]
    return idx, valid


def sparse_attend(q, k_g, v_g, valid):
    b, nq = q.shape[:2]
    logits = jnp.einsum('bqcgd,bqkcd->bqcgk', q, k_g).astype(jnp.float32) * (HEAD_DIM ** -0.5)
    logits = jnp.where(valid[:, :, None, None, :], logits, -jnp.inf)
    p = jax.nn.softmax(logits, axis=-1).astype(v_g.dtype)
    o = jnp.einsum('bqcgk,bqkcd->bqcgd', p, v_g)
    return o.reshape(b, nq, D_ATT)


def dsa_prompt(q_a, k_a, v_a, q_i, k_i, w_i):
    b, t = q_a.shape[:2]
    n_sel = min(TOPK_MAX, t // 4)
    qb = min(Q_BLOCK, t)
    nb = t // qb
    def blocks(a):
        return jnp.moveaxis(a.reshape((b, nb, qb) + a.shape[2:]), 1, 0)
    starts = jnp.arange(nb, dtype=jnp.int32) * qb
    gather_rows = jax.vmap(lambda rows, ids: rows[ids])
    def one_block(args):
        qa, qi, wi, st = args
        q_pos = st + jnp.arange(qb, dtype=jnp.int32)
        idx, valid = indexer_select(qi, wi, k_i, q_pos, n_sel)
        return sparse_attend(qa, gather_rows(k_a, idx), gather_rows(v_a, idx), valid)
    out = lax.map(one_block, (blocks(q_a), blocks(q_i), blocks(w_i), starts))
    return jnp.moveaxis(out, 0, 1).reshape(b, t, D_ATT)


def dsa_sample(q_a, k_a, v_a, q_i, k_i, w_i, pool_k, pool_v, pool_ki, page_table):
    db, ds = q_a.shape[:2]
    page = pool_k.shape[1]
    past = page_table.shape[1] * page
    n_sel = min(TOPK_MAX, (past + ds) // 4)
    ki_past = pool_ki[page_table].reshape(db, past, D_IDX)
    ki_all = jnp.concatenate([ki_past.astype(k_i.dtype), k_i], axis=1)
    q_pos = past + jnp.arange(ds, dtype=jnp.int32)
    idx, valid = indexer_select(q_i, w_i, ki_all, q_pos, n_sel)
    b_ix = jnp.arange(db)[:, None, None]
    in_past = (idx < past)[..., None, None]
    pidx = jnp.minimum(idx, past - 1)
    phys = page_table[b_ix, pidx // page]
    off = pidx % page
    nidx = jnp.clip(idx - past, 0, ds - 1)
    k_g = jnp.where(in_past, pool_k[phys, off].astype(k_a.dtype), k_a[b_ix, nidx])
    v_g = jnp.where(in_past, pool_v[phys, off].astype(v_a.dtype), v_a[b_ix, nidx])
    return sparse_attend(q_a, k_g, v_g, valid)


def merge_heads(o_r, g_r, o_a, g_a, ret_g, w_out):
    b, t = o_r.shape[:2]
    r = head_group_norm(o_r, ret_g).reshape(b, t, D_RET) * jax.nn.silu(g_r)
    a = o_a * jax.nn.silu(g_a)
    return jnp.concatenate([r, a], axis=-1) @ w_out


def setup_inputs(seed: int = 0) -> dict:
    key = jax.random.key(seed)
    ks = jax.random.split(key, 12)
    n_pages = PAST_LEN // PAGE_SIZE
    n_used = DEC_BATCH * n_pages
    n_phys = n_used + (n_used + 3) // 4
    f32 = jnp.float32
    x_prompt = jax.random.normal(ks[0], (BATCH, SEQ, D_MODEL), f32)
    x_sample = jax.random.normal(ks[1], (DEC_BATCH, DEC_SEQ, D_MODEL), f32)
    cache_k = jax.random.normal(ks[2], (DEPTH, n_phys, PAGE_SIZE, N_KV_HEADS, HEAD_DIM), f32)
    cache_v = jax.random.normal(ks[3], (DEPTH, n_phys, PAGE_SIZE, N_KV_HEADS, HEAD_DIM), f32)
    cache_kidx = jax.random.normal(ks[4], (DEPTH, n_phys, PAGE_SIZE, D_IDX), f32)
    state_ret = jax.random.normal(ks[5], (DEPTH, DEC_BATCH, N_RET_HEADS, HEAD_DIM, HEAD_DIM), f32)
    page_table = jax.random.permutation(ks[6], n_phys)[:n_used].reshape(DEC_BATCH, n_pages).astype(jnp.int32)
    norm_g = 1.0 + 0.02 * jax.random.normal(ks[7], (DEPTH, D_MODEL), f32)
    w_in = jax.random.normal(ks[8], (DEPTH, D_MODEL, D_IN_PROJ), f32) * (D_MODEL ** -0.5)
    ret_norm_g = 1.0 + 0.02 * jax.random.normal(ks[9], (DEPTH, N_RET_HEADS, HEAD_DIM), f32)
    w_out = jax.random.normal(ks[10], (DEPTH, D_MIX, D_MODEL), f32) * (D_MIX ** -0.5)
    final_norm_g = 1.0 + 0.02 * jax.random.normal(ks[11], (D_MODEL,), f32)
    return {"x_prompt": x_prompt, "x_sample": x_sample, "cache_k": cache_k, "cache_v": cache_v,
            "cache_kidx": cache_kidx, "state_ret": state_ret, "page_table": page_table,
            "norm_g": norm_g, "w_in": w_in, "ret_norm_g": ret_norm_g, "w_out": w_out,
            "final_norm_g": final_norm_g}


def reference(x_prompt, x_sample, cache_k, cache_v, cache_kidx, state_ret, page_table,
              norm_g, w_in, ret_norm_g, w_out, final_norm_g):
    log_g = retention_log_decay()
    t = x_prompt.shape[1]
    ds = x_sample.shape[1]
    past = page_table.shape[1] * cache_k.shape[2]
    pos_p = jnp.arange(t, dtype=jnp.int32)
    pos_s = past + jnp.arange(ds, dtype=jnp.int32)
    hp, hs = x_prompt, x_sample
    pk, pv, pki, pst = [], [], [], []
    sk, sv, ski, sst = [], [], [], []
    for l in range(DEPTH):
        q_r, k_r, v_r, g_r, q_a, k_a, v_a, g_a, q_i, k_i, w_i = project(hp, norm_g[l], w_in[l], pos_p)
        o_r, s_fin = retention_prompt(q_r, k_r, v_r, log_g)
        o_a = dsa_prompt(q_a, k_a, v_a, q_i, k_i, w_i)
        hp = hp + merge_heads(o_r, g_r, o_a, g_a, ret_norm_g[l], w_out[l])
        pk.append(k_a); pv.append(v_a); pki.append(k_i); pst.append(s_fin)
        q_r, k_r, v_r, g_r, q_a, k_a, v_a, g_a, q_i, k_i, w_i = project(hs, norm_g[l], w_in[l], pos_s)
        o_r, s_new = retention_chunk(q_r, k_r, v_r, state_ret[l], log_g)
        o_a = dsa_sample(q_a, k_a, v_a, q_i, k_i, w_i, cache_k[l], cache_v[l], cache_kidx[l], page_table)
        hs = hs + merge_heads(o_r, g_r, o_a, g_a, ret_norm_g[l], w_out[l])
        sk.append(k_a); sv.append(v_a); ski.append(k_i); sst.append(s_new)
    y_prompt = rmsnorm(hp, final_norm_g)
    y_sample = rmsnorm(hs, final_norm_g)
    return (y_prompt, y_sample, jnp.stack(pk), jnp.stack(pv), jnp.stack(pki), jnp.stack(pst),
            jnp.stack(sk), jnp.stack(sv), jnp.stack(ski), jnp.stack(sst))
```

```cpp
#include <hip/hip_runtime.h>
#include <cstdint>
#include <cstdio>

#define DI __device__ __forceinline__
#define LAS __attribute__((address_space(3)))
#define GAS __attribute__((address_space(1)))
typedef unsigned short bf16_t;
typedef short bf16x8 __attribute__((ext_vector_type(8)));
typedef short s16x4 __attribute__((ext_vector_type(4)));
typedef float f32x2 __attribute__((ext_vector_type(2)));
typedef float f32x4 __attribute__((ext_vector_type(4)));
typedef float f32x16 __attribute__((ext_vector_type(16)));
typedef unsigned u32x2 __attribute__((ext_vector_type(2)));
typedef unsigned u32x4 __attribute__((ext_vector_type(4)));
typedef __bf16 bf16x2_t __attribute__((ext_vector_type(2)));

#ifndef MK_N_LAUNCHES
#define MK_N_LAUNCHES 1
#endif

constexpr int DM = 2048, NB = 4, SEQ = 2048, MP = NB * SEQ  , DB = 8  , PAST = 16384, PAGE = 128, NPAGES = PAST / PAGE;
constexpr int HD = 128, NRH = 8, NAH = 8, NKV = 2, DKV = 256, NIH = 16, DIDX = 128, TOPK = 256, CH = 128  , NCH = SEQ / CH;
constexpr int DIN = 8848, DINP = 8960;
constexpr int C_QR = 0, C_KR = 1024, C_VR = 2048, C_GR = 3072, C_QA = 4096, C_KA = 5120, C_VA = 5376, C_GA = 5632, C_QI = 6656, C_KI = 8704, C_WI = 8832;
constexpr float EPS = 1e-6f;
constexpr float KSCALE = 0.08838834764831845f;
constexpr float QA_SCALE = 0.08838834764831845f * 1.4426950408889634f;
constexpr float WI_SCALE = 0.022097086912079608f;
constexpr size_t O_Y = 0, O_YS = 16777216, O_NK = 16793600, O_NV = 18890752, O_NKI = 20987904, O_ST = 22036480, O_NKS = 22560768, O_NVS = 22562816, O_NKIS = 22564864, O_STS = 22565888;
constexpr size_t MiB = 1u << 20;
constexpr size_t WS_CTL = 0, CTL_ZERO_BYTES = 1 * MiB;
constexpr size_t WS_WT = 2 * MiB;
constexpr size_t WS_WOT = 40 * MiB;
constexpr size_t WS_XN = 48 * MiB;
constexpr size_t WS_QR = 80 * MiB;
constexpr size_t WS_KR = 96 * MiB, WS_VR = 112 * MiB, WS_GR = 128 * MiB, WS_QA = 144 * MiB, WS_GA = 160 * MiB;
constexpr size_t WS_KA = 176 * MiB;
constexpr size_t WS_VA = 180 * MiB;
constexpr size_t WS_QI = 184 * MiB;
constexpr size_t WS_KI = 216 * MiB;
constexpr size_t WS_WI = 218 * MiB;
constexpr size_t WS_CS = 219 * MiB;
constexpr size_t WS_XNS = 221 * MiB;
constexpr size_t WS_ZS = 222 * MiB;
constexpr size_t WS_ACTS = 223 * MiB;
constexpr size_t WS_SCS = 224 * MiB;
constexpr size_t WS_PART = 225 * MiB;
constexpr size_t WS_MASK = 226 * MiB;
constexpr size_t WS_KV = 228 * MiB;
constexpr size_t WS_SP = 260 * MiB;
constexpr size_t WS_ACT = 276 * MiB;
constexpr size_t WS_END = 308 * MiB;

__device__ const float ROPE_INV[64] = {
1.f, 0.865964353f, 0.749894261f, 0.649381638f, 0.562341332f, 0.486967534f, 0.421696514f, 0.365174115f, 0.316227764f, 0.273841977f, 0.237137377f, 0.2053525f, 0.177827939f, 0.153992653f, 0.133352131f, 0.115478203f,
0.100000001f, 0.0865964293f, 0.0749894157f, 0.0649381652f, 0.0562341325f, 0.0486967526f, 0.0421696529f, 0.0365174115f, 0.0316227749f, 0.0273841973f, 0.0237137377f, 0.0205352511f, 0.0177827943f, 0.0153992651f, 0.0133352149f, 0.0115478206f,
0.00999999978f, 0.00865964312f, 0.00749894185f, 0.00649381615f, 0.00562341325f, 0.00486967526f, 0.00421696482f, 0.00365174119f, 0.00316227763f, 0.00273841969f, 0.00237137359f, 0.00205352483f, 0.00177827943f, 0.00153992651f, 0.00133352145f, 0.0011547819f,
0.00100000005f, 0.000865964335f, 0.000749894243f, 0.000649381662f, 0.000562341302f, 0.000486967532f, 0.000421696517f, 0.000365174143f, 0.000316227757f, 0.000273841957f, 0.00023713737f, 0.00020535251f, 0.00017782794f, 0.000153992645f, 0.00013335215f, 0.0001154782f};
DI float l2g(int h) {
    const float t[8] = {-0.04580368961312479f, -0.02272007650008353f, -0.011315313227834146f, -0.005646563141142063f, -0.0028205190623786626f, -0.0014095702546713536f, -0.0007046129765893727f, -0.0003522634716290214f};
    float r = t[0];
#pragma unroll
    for (int i = 1; i < 8; ++i) r = (h == i) ? t[i] : r;
    return r;
}

#define LDS_WAIT() asm volatile("s_waitcnt lgkmcnt(0)" ::: "memory")
#define VM_WAIT() asm volatile("s_waitcnt vmcnt(0)" ::: "memory")
DI unsigned cvtpk(float lo, float hi) { f32x2 v = {lo, hi}; bf16x2_t b = __builtin_convertvector(v, bf16x2_t); return __builtin_bit_cast(unsigned, b); }
DI float bf2f(unsigned short b) { return __uint_as_float((unsigned)b << 16); }
DI float bflo(unsigned w) { return __uint_as_float(w << 16); }
DI float bfhi(unsigned w) { return __uint_as_float(w & 0xffff0000u); }
DI float wave_sum(float v) {
#pragma unroll
    for (int o = 1; o < 64; o <<= 1) v += __shfl_xor(v, o);
    return v;
}
DI float silu(float x) { return x / (1.f + __expf(-x)); }
DI unsigned fkey(float s) { const unsigned b = __float_as_uint(s); return (b & 0x80000000u) ? ~b : (b | 0x80000000u); }

namespace pg8 {
constexpr int BM = 256, BK = 64, HALF = 128, HTB = HALF * BK * 2, STAGE_BYTES = 8 * HTB, NXCD = 8, WGM = 8;
DI int lds_byte(int r, int c) { const int st = (r >> 4) * 2 + (c >> 5), rr = r & 15, cc = c & 31, ob = rr * 64 + cc * 2; return st * 1024 + (ob ^ (((ob >> 9) & 1) << 5)); }
DI void stage_rc(int b, int& R, int& C) { const int st = b / 1024, sb = b % 1024, swz = sb ^ (((sb >> 9) & 1) << 5); R = (st >> 1) * 16 + swz / 64; C = (st & 1) * 32 + (swz % 64) / 2; }
DI int perm32(int rho) { const int n = rho >> 4, i = rho & 15; return 8 * (i >> 2) + 4 * n + (i & 3); }
struct Unit { int pm, pn; };
struct Gemm { const bf16_t* A; const bf16_t* Bt; int M, N, K; };
struct StaticOrder {
    int nM, nN, nwg, G, c;
    DI void init(int M, int N, int G_, int c_) { nM = M / BM; nN = N / BM; nwg = nM * nN; G = G_; c = c_; }
    DI bool next(int i, Unit& u) const {
        const long L = (long)i * G + c; if (L >= nwg) return false;
        int wgid = (int)L; { const int q = nwg / NXCD, r = nwg % NXCD, xcd = wgid % NXCD, off = wgid / NXCD; wgid = (xcd < r ? xcd * (q + 1) : r * (q + 1) + (xcd - r) * q) + off; }
        const int nig = WGM * nN, gid = wgid / nig, fm = gid * WGM, gsz = (nM - fm) < WGM ? (nM - fm) : WGM;
        u.pm = fm + ((wgid % nig) % gsz); u.pn = (wgid % nig) / gsz; return true;
    }
    DI void a_ready(const Unit&) const {}
    DI void done(const Unit&) const {}
};

template <class Epi, class Sched, bool ALIGN_EPI = false, bool SP2 = false>
DI void gemm_phase(LAS unsigned char* lds, const Gemm g, const Sched& S, const Epi& E) {
    const int tid = threadIdx.x, wid = __builtin_amdgcn_readfirstlane(tid >> 6), lane = tid & 63, wr = wid >> 2, wc = wid & 3, fr = lane & 15, fq = lane >> 4;
    const int K = g.K, nt = K / BK;
    unsigned voffA[2], voffB[2];
#pragma unroll
    for (int i = 0; i < 2; ++i) { int R, C; stage_rc(tid * 16 + i * 8192, R, C); const int Rb = Epi::PERM ? ((R & ~31) + perm32(R & 31)) : R;
        voffA[i] = (unsigned)(R * K + C) * 2u; voffB[i] = (unsigned)(Rb * K + C) * 2u; }
    const size_t kstep = (size_t)(BK * 2);
    const size_t hstep = (size_t)HALF * K * 2;
    const size_t tstep = 2 * hstep;
    const unsigned ldsw = (unsigned)wid * 1024u;
    const int aoff = lds_byte(wr * 64 + fr, fq * 8), boff = lds_byte(wc * 32 + fr, fq * 8);
#define PG8_SA(b, h) (((b) * 2 + (h)) * HTB)
#define PG8_SB(b, h) ((4 + (b) * 2 + (h)) * HTB)
#define PG8_STAGE(bufoff, gbase, voff) do { _Pragma("unroll") for (int _i = 0; _i < 2; ++_i) \
        __builtin_amdgcn_global_load_lds((const unsigned*)((const char*)(gbase) + (voff)[_i]), (LAS unsigned*)(lds + (bufoff) + ldsw + _i * 8192), 16, 0, 0); } while (0)
#define PG8_LDA(dst, b, h) do { _Pragma("unroll") for (int m = 0; m < 4; ++m) _Pragma("unroll") for (int k = 0; k < 2; ++k) dst[m][k] = *(const LAS bf16x8*)(lds + PG8_SA(b, h) + aoff + m * 2048 + k * 1024); } while (0)
#define PG8_LDB(dst, b, h) do { _Pragma("unroll") for (int n = 0; n < 2; ++n) _Pragma("unroll") for (int k = 0; k < 2; ++k) dst[n][k] = *(const LAS bf16x8*)(lds + PG8_SB(b, h) + boff + n * 2048 + k * 1024); } while (0)
#define PG8_MMA(ai, bj, At, Bt) do { __builtin_amdgcn_s_setprio(1); _Pragma("unroll") for (int m = 0; m < 4; ++m) _Pragma("unroll") for (int n = 0; n < 2; ++n) _Pragma("unroll") for (int k = 0; k < 2; ++k) \
        acc[ai][bj][m][n] = __builtin_amdgcn_mfma_f32_16x16x32_bf16(Bt[n][k], At[m][k], acc[ai][bj][m][n], 0, 0, 0); __builtin_amdgcn_s_setprio(0); } while (0)
#define PG8_WAIT_V(n) asm volatile("s_waitcnt vmcnt(" #n ")" ::: "memory")
#define PG8_WAIT_L(n) asm volatile("s_waitcnt lgkmcnt(" #n ")" ::: "memory")
#define PG8_BAR __builtin_amdgcn_s_barrier()
#define PG8_SCHED __builtin_amdgcn_sched_barrier(0)
    Unit cur, nxt; int ui = 0;
    if (!S.next(0, cur)) return;
    f32x4 acc[2][2][4][2];
#pragma unroll
    for (int a = 0; a < 2; ++a)
#pragma unroll
        for (int b = 0; b < 2; ++b)
#pragma unroll
            for (int m = 0; m < 4; ++m)
#pragma unroll
                for (int n = 0; n < 2; ++n) acc[a][b][m][n] = (f32x4){0.f, 0.f, 0.f, 0.f};
    bf16x8 At[4][2], B0[2][2], B1[2][2];
    const char* cA = (const char*)g.A + (size_t)cur.pm * tstep; const char* cB = (const char*)g.Bt + (size_t)cur.pn * tstep;
    S.a_ready(cur);
    if constexpr (SP2) {
        PG8_STAGE(PG8_SB(0, 0), cB, voffB); PG8_STAGE(PG8_SB(0, 1), cB + hstep, voffB); PG8_STAGE(PG8_SA(0, 0), cA, voffA); PG8_STAGE(PG8_SA(0, 1), cA + hstep, voffA);
        if (wr == 1) PG8_BAR;
        PG8_WAIT_V(2); PG8_BAR;
        PG8_STAGE(PG8_SB(1, 0), cB + kstep, voffB); PG8_STAGE(PG8_SA(1, 0), cA + kstep, voffA); PG8_STAGE(PG8_SB(1, 1), cB + hstep + kstep, voffB);
        PG8_WAIT_V(6); PG8_BAR;
    } else {
        PG8_STAGE(PG8_SB(0, 0), cB, voffB); PG8_STAGE(PG8_SA(0, 0), cA, voffA); PG8_STAGE(PG8_SB(0, 1), cB + hstep, voffB); PG8_STAGE(PG8_SA(0, 1), cA + hstep, voffA);
        if (wr == 1) PG8_BAR;
        PG8_WAIT_V(4); PG8_BAR;
        PG8_STAGE(PG8_SB(1, 0), cB + kstep, voffB); PG8_STAGE(PG8_SA(1, 0), cA + kstep, voffA); PG8_STAGE(PG8_SB(1, 1), cB + hstep + kstep, voffB);
        PG8_WAIT_V(6); PG8_BAR;
    }
    for (;;) {
        const bool has_next = S.next(ui + 1, nxt);
        const char* nA = has_next ? (const char*)g.A + (size_t)nxt.pm * tstep : cA; const char* nB = has_next ? (const char*)g.Bt + (size_t)nxt.pn * tstep : cB;
        for (int t = 0; t < nt; t += 2) {
            const bool last = (t == nt - 2);
            const char* a1 = cA + (size_t)(t + 1) * kstep;
            const char* a2 = last ? nA : cA + (size_t)(t + 2) * kstep; const char* b2 = last ? nB : cB + (size_t)(t + 2) * kstep;
            const char* a3 = a2 + kstep; const char* b3 = b2 + kstep;
            if (last && has_next) S.a_ready(nxt);
            if constexpr (SP2) {
            PG8_LDB(B0, 0, 0); PG8_LDB(B1, 0, 1); PG8_SCHED; PG8_LDA(At, 0, 0); PG8_STAGE(PG8_SA(1, 1), a1 + hstep, voffA);
            PG8_WAIT_V(8); PG8_WAIT_L(0); PG8_BAR; PG8_MMA(0, 0, At, B0); PG8_MMA(0, 1, At, B1); PG8_BAR; PG8_SCHED;
            PG8_LDA(At, 0, 1); PG8_STAGE(PG8_SB(0, 0), b2, voffB); PG8_STAGE(PG8_SB(0, 1), b2 + hstep, voffB); PG8_STAGE(PG8_SA(0, 0), a2, voffA);
            PG8_WAIT_V(8); PG8_WAIT_L(0); PG8_BAR; PG8_MMA(1, 0, At, B0); PG8_MMA(1, 1, At, B1); PG8_BAR; PG8_SCHED;
            PG8_LDB(B0, 1, 0); PG8_LDB(B1, 1, 1); PG8_SCHED; PG8_LDA(At, 1, 0); PG8_STAGE(PG8_SA(0, 1), a2 + hstep, voffA);
            PG8_WAIT_V(8); PG8_WAIT_L(0); PG8_BAR; PG8_MMA(0, 0, At, B0); PG8_MMA(0, 1, At, B1); PG8_BAR; PG8_SCHED;
            PG8_LDA(At, 1, 1); PG8_STAGE(PG8_SB(1, 0), b3, voffB); PG8_STAGE(PG8_SB(1, 1), b3 + hstep, voffB); PG8_STAGE(PG8_SA(1, 0), a3, voffA);
            PG8_WAIT_V(8); PG8_WAIT_L(0); PG8_BAR; PG8_MMA(1, 0, At, B0); PG8_MMA(1, 1, At, B1); PG8_BAR; PG8_SCHED;
            } else {
            PG8_LDB(B0, 0, 0); PG8_SCHED; PG8_LDA(At, 0, 0); PG8_STAGE(PG8_SA(1, 1), a1 + hstep, voffA);
            PG8_WAIT_L(8); PG8_BAR; PG8_WAIT_L(0); PG8_MMA(0, 0, At, B0); PG8_BAR; PG8_SCHED;
            PG8_LDB(B1, 0, 1); PG8_STAGE(PG8_SB(0, 0), b2, voffB);
            PG8_BAR; PG8_WAIT_L(0); PG8_MMA(0, 1, At, B1); PG8_BAR;
            PG8_LDA(At, 0, 1); PG8_STAGE(PG8_SA(0, 0), a2, voffA);
            PG8_BAR; PG8_WAIT_L(0); PG8_MMA(1, 0, At, B0); PG8_BAR; PG8_SCHED;
            PG8_STAGE(PG8_SB(0, 1), b2 + hstep, voffB);
            PG8_WAIT_V(6); PG8_BAR; PG8_MMA(1, 1, At, B1); PG8_BAR;
            PG8_LDB(B0, 1, 0); PG8_SCHED; PG8_LDA(At, 1, 0); PG8_STAGE(PG8_SA(0, 1), a2 + hstep, voffA);
            PG8_WAIT_L(8); PG8_BAR; PG8_WAIT_L(0); PG8_MMA(0, 0, At, B0); PG8_BAR; PG8_SCHED;
            PG8_LDB(B1, 1, 1); PG8_STAGE(PG8_SB(1, 0), b3, voffB);
            PG8_BAR; PG8_WAIT_L(0); PG8_MMA(0, 1, At, B1); PG8_BAR;
            PG8_LDA(At, 1, 1); PG8_STAGE(PG8_SA(1, 0), a3, voffA);
            PG8_BAR; PG8_WAIT_L(0); PG8_MMA(1, 0, At, B0); PG8_BAR; PG8_SCHED;
            PG8_STAGE(PG8_SB(1, 1), b3 + hstep, voffB);
            PG8_WAIT_V(6); PG8_BAR; PG8_MMA(1, 1, At, B1); PG8_BAR;
            }
        }
        if constexpr (ALIGN_EPI) { if (wr == 0) PG8_BAR; }
        if constexpr (!Epi::AFTER_DRAIN) { E(acc, cur, wr, wc, fr, fq); S.done(cur); }
        if (!has_next) break;
#pragma unroll
        for (int a = 0; a < 2; ++a)
#pragma unroll
            for (int b = 0; b < 2; ++b)
#pragma unroll
                for (int m = 0; m < 4; ++m)
#pragma unroll
                    for (int n = 0; n < 2; ++n) acc[a][b][m][n] = (f32x4){0.f, 0.f, 0.f, 0.f};
        cur = nxt; cA = nA; cB = nB; ++ui;
        if constexpr (ALIGN_EPI) { if (wr == 1) PG8_BAR; }
    }
    PG8_WAIT_V(0);
    if constexpr (!ALIGN_EPI) { if (wr == 0) PG8_BAR; }
    PG8_BAR;
#undef PG8_SA
#undef PG8_SB
#undef PG8_STAGE
#undef PG8_LDA
#undef PG8_LDB
#undef PG8_MMA
#undef PG8_WAIT_V
#undef PG8_WAIT_L
#undef PG8_BAR
#undef PG8_SCHED
}
}

DI int cmap_in(int c) {
    if (c >= DIN) return -1;
    if (c >= C_VR) return c;
    const int hb = c & ~127, s = c & 127, g = s >> 3, e = s & 7;
    return hb + ((e < 4) ? (4 * g + e) : (64 + 4 * g + (e - 4)));
}

struct EpiInProj {
    static constexpr bool PERM = true, AFTER_DRAIN = false;
    bf16_t *QR, *KR, *VR, *GR, *QA, *KA, *VA, *GA, *QI, *KI; float* WI; float *oK, *oV, *oKI; const float* CS;
    DI void operator()(const f32x4 (&acc)[2][2][4][2], const pg8::Unit& u, int wr, int wc, int fr, int fq) const {
        const int pn = u.pn, rowb = u.pm * 256 + wr * 64 + fr, cl = wc * 32 + 8 * fq;
        if (pn < 8) {
            const bool isq = pn < 4; bf16_t* dst = isq ? QR : KR; const int g4 = 4 * (4 * wc + fq);
#pragma unroll
            for (int ai = 0; ai < 2; ++ai)
#pragma unroll
                for (int m = 0; m < 4; ++m) {
                    const int row = rowb + ai * 128 + m * 16, pos = row & (SEQ - 1), ic = pos & (CH - 1);
                    const f32x4 cs = *(const f32x4*)(CS + (size_t)pos * 128 + g4), sn = *(const f32x4*)(CS + (size_t)pos * 128 + 64 + g4);
#pragma unroll
                    for (int bj = 0; bj < 2; ++bj) {
                        const int head = 2 * (pn & 3) + bj;
                        const float lg = l2g(head) * (float)(ic + 1);
                        const float sc = isq ? __builtin_amdgcn_exp2f(lg) : KSCALE * __builtin_amdgcn_exp2f(-lg);
                        const f32x4 x1 = acc[ai][bj][m][0], x2 = acc[ai][bj][m][1];
                        const f32x4 o1 = (x1 * cs - x2 * sn) * sc, o2 = (x1 * sn + x2 * cs) * sc;
                        bf16_t* p = dst + (size_t)row * 1024 + head * 128 + g4;
                        *(u32x2*)p = (u32x2){cvtpk(o1[0], o1[1]), cvtpk(o1[2], o1[3])};
                        *(u32x2*)(p + 64) = (u32x2){cvtpk(o2[0], o2[1]), cvtpk(o2[2], o2[3])};
                    }
                }
            return;
        }
        int kind; bf16_t* bdst = nullptr; int ld = 0, cbase = 0; float* fdst = nullptr; int fld = 0;
        if (pn < 12) { kind = 0; bdst = VR; ld = 1024; cbase = (pn - 8) * 256; }
        else if (pn < 16) { kind = 1; bdst = GR; ld = 1024; cbase = (pn - 12) * 256; }
        else if (pn < 20) { kind = 2; bdst = QA; ld = 1024; cbase = (pn - 16) * 256; }
        else if (pn == 20) { kind = 3; bdst = KA; ld = 256; cbase = 0; fdst = oK; fld = 256; }
        else if (pn == 21) { kind = 3; bdst = VA; ld = 256; cbase = 0; fdst = oV; fld = 256; }
        else if (pn < 26) { kind = 1; bdst = GA; ld = 1024; cbase = (pn - 22) * 256; }
        else if (pn < 34) { kind = 0; bdst = QI; ld = 2048; cbase = (pn - 26) * 256; }
        else { kind = 4; }
#pragma unroll
        for (int ai = 0; ai < 2; ++ai)
#pragma unroll
            for (int m = 0; m < 4; ++m) {
                const int row = rowb + ai * 128 + m * 16;
#pragma unroll
                for (int bj = 0; bj < 2; ++bj) {
                    f32x4 v0 = acc[ai][bj][m][0], v1 = acc[ai][bj][m][1];
                    const int col = bj * 128 + cl;
                    if (kind == 4) {
                        if (bj == 0) {
                            *(f32x4*)(oKI + (size_t)row * 128 + col) = v0; *(f32x4*)(oKI + (size_t)row * 128 + col + 4) = v1;
                            *(u32x4*)(KI + (size_t)row * 128 + col) = (u32x4){cvtpk(v0[0], v0[1]), cvtpk(v0[2], v0[3]), cvtpk(v1[0], v1[1]), cvtpk(v1[2], v1[3])};
                        } else if (cl < 16) {
                            *(f32x4*)(WI + (size_t)row * 16 + cl) = v0 * WI_SCALE; *(f32x4*)(WI + (size_t)row * 16 + cl + 4) = v1 * WI_SCALE;
                        }
                        continue;
                    }
                    if (kind == 3) { *(f32x4*)(fdst + (size_t)row * fld + col) = v0; *(f32x4*)(fdst + (size_t)row * fld + col + 4) = v1; }
                    if (kind == 1) {
#pragma unroll
                        for (int e = 0; e < 4; ++e) { v0[e] = silu(v0[e]); v1[e] = silu(v1[e]); }
                    }
                    if (kind == 2) { v0 = v0 * QA_SCALE; v1 = v1 * QA_SCALE; }
                    *(u32x4*)(bdst + (size_t)row * ld + cbase + col) = (u32x4){cvtpk(v0[0], v0[1]), cvtpk(v0[2], v0[3]), cvtpk(v1[0], v1[1]), cvtpk(v1[2], v1[3])};
                }
            }
    }
};

struct EpiOutProj {
    static constexpr bool PERM = false, AFTER_DRAIN = false;
    const float* X; float* Y; float* PART;
    DI void operator()(const f32x4 (&acc)[2][2][4][2], const pg8::Unit& u, int wr, int wc, int fr, int fq) const {
        const int rowb = u.pm * 256 + wr * 64 + fr, col0 = u.pn * 256 + wc * 32 + 4 * fq;
#pragma unroll
        for (int ai = 0; ai < 2; ++ai)
#pragma unroll
            for (int m = 0; m < 4; ++m) {
                const int row = rowb + ai * 128 + m * 16; float ss = 0.f;
#pragma unroll
                for (int bj = 0; bj < 2; ++bj)
#pragma unroll
                    for (int n = 0; n < 2; ++n) {
                        const size_t off = (size_t)row * DM + col0 + bj * 128 + n * 16;
                        const f32x4 h = *(const f32x4*)(X + off) + acc[ai][bj][m][n];
                        *(f32x4*)(Y + off) = h; ss += (h[0] * h[0] + h[1] * h[1]) + (h[2] * h[2] + h[3] * h[3]);
                    }
                ss += __shfl_xor(ss, 16); ss += __shfl_xor(ss, 32);
                if (fq == 0) PART[(size_t)row * 32 + u.pn * 4 + wc] = ss;
            }
    }
};

DI unsigned tile_off(unsigned row, unsigned ch) { return 256u * row + 16u * (ch ^ (((row & 3) << 2) | ((row >> 2) & 3))); }
DI unsigned vtile_off(unsigned row, unsigned ch) { return 256u * row + 16u * (ch ^ (((row & 3) << 2) | (((row >> 2) & 1) << 1))); }
typedef short v4i16_t __attribute__((ext_vector_type(4)));
DI s16x4 tr4(const LAS char* p) { return __builtin_bit_cast(s16x4, __builtin_amdgcn_ds_read_tr16_b64_v4i16((LAS v4i16_t*)p)); }
DI bf16x8 row_frag(const LAS char* img, int row0, int lane, int s) { return *(const LAS bf16x8*)(img + tile_off(row0 + (lane & 31), 2 * s + (lane >> 5))); }
DI bf16x8 tr_frag(const LAS char* img, int krow0, int col0, int lane) {
    const unsigned h = lane >> 5, blk = (lane >> 4) & 1, q = (lane & 15) >> 2, p = lane & 3, ch = (col0 >> 3) + 2 * blk + (p >> 1);
    const s16x4 lo = tr4(img + tile_off(krow0 + 8 * h + q, ch) + 8 * (p & 1)), hi = tr4(img + tile_off(krow0 + 8 * h + 4 + q, ch) + 8 * (p & 1));
    return __builtin_shufflevector(lo, hi, 0, 1, 2, 3, 4, 5, 6, 7);
}
DI bf16x8 tr_frag_perm(const LAS char* img, int krow0, int col0, int lane) {
    const unsigned h = lane >> 5, blk = (lane >> 4) & 1, q = (lane & 15) >> 2, p = lane & 3, ch = (col0 >> 3) + 2 * blk + (p >> 1);
    const s16x4 lo = tr4(img + tile_off(krow0 + 4 * h + q, ch) + 8 * (p & 1)), hi = tr4(img + tile_off(krow0 + 8 + 4 * h + q, ch) + 8 * (p & 1));
    return __builtin_shufflevector(lo, hi, 0, 1, 2, 3, 4, 5, 6, 7);
}
DI bf16x8 row_frag16(const LAS char* img, int row0, int lane, int s) { return *(const LAS bf16x8*)(img + tile_off(row0 + (lane & 15), 4 * s + (lane >> 4))); }
DI bf16x8 tr16_perm(const LAS char* img, int krow0, int c8, int lane) {
    const unsigned g = lane >> 4, q = (lane & 15) >> 2, p = lane & 3, ch = 2 * c8 + (p >> 1);
    const s16x4 lo = tr4(img + vtile_off(krow0 + 4 * g + q, ch) + 8 * (p & 1)), hi = tr4(img + vtile_off(krow0 + 16 + 4 * g + q, ch) + 8 * (p & 1));
    return __builtin_shufflevector(lo, hi, 0, 1, 2, 3, 4, 5, 6, 7);
}
template <int NROWS, bool VT> DI void load_tile(LAS char* img, const char* g, size_t gstride, int tid) {
#pragma unroll
    for (int i = 0; i < NROWS * 16 / 512; ++i) {
        const int n = tid + 512 * i, row = n >> 4, ch = n & 15;
        const u32x4 v = *(const u32x4*)(g + (size_t)row * gstride + ch * 16);
        *(LAS u32x4*)(img + (VT ? vtile_off(row, ch) : tile_off(row, ch))) = v;
    }
}
DI f32x16 zero16() { f32x16 z;
#pragma unroll
    for (int i = 0; i < 16; ++i) z[i] = 0.f;
    return z; }
DI int crow(int r, int h) { return (r & 3) + 8 * (r >> 2) + 4 * h; }
#define MFMA32(a, b, c) __builtin_amdgcn_mfma_f32_32x32x16_bf16((a), (b), (c), 0, 0, 0)
#define MFMA16(a, b, c) __builtin_amdgcn_mfma_f32_16x16x32_bf16((a), (b), (c), 0, 0, 0)

constexpr int NWAVES = 8, NTHR = 512;
constexpr int RING_BYTES = 131072, MISC_OFF = RING_BYTES + 320, LDS_BYTES = 147456;
struct Frame {
    LAS unsigned char* lds; volatile LAS unsigned* MISC; unsigned* ctl;
    int tid, lane, wave, G, bid;
    const float *x, *xs, *cache_k, *cache_v, *cache_ki, *state, *norm_g, *w_in, *ret_g, *w_out, *fin_g; const int* ptab;
    float* out; unsigned char* ws;
};

#define XB_TMO      128
#define XB_XCNT(j)  (256  + 64 * (j))
#define XB_XSUB(j)  (1280 + 64 * (j))
#define XB_XGEN(j)  (2304 + 64 * (j))
#define XB_TOP      3328
#define XB_TOPGEN   3392
#define XCD_BAR_WORDS 3456
#define XB_SPIN_CAP (1u << 20)
constexpr int CW_BAR = 4096;
DI unsigned xb_ld(unsigned* p) { return __hip_atomic_load(p, __ATOMIC_RELAXED, __HIP_MEMORY_SCOPE_AGENT); }
DI unsigned xb_add(unsigned* p, unsigned v) { return __hip_atomic_fetch_add(p, v, __ATOMIC_RELAXED, __HIP_MEMORY_SCOPE_AGENT); }
DI unsigned xb_xcc_id() { return (unsigned)__builtin_amdgcn_s_getreg((3 << 11) | 20) & 0xFu; }
#define XB_SPIN(cond, bar) do { unsigned _sp = 0; while (cond) { __builtin_amdgcn_s_sleep(1); \
    if ((++_sp & 255u) == 0u) { if (xb_ld(&(bar)[XB_TMO])) break; if (_sp > XB_SPIN_CAP) { atomicAdd(&(bar)[XB_TMO], 1u); break; } } } } while (0)
struct XcdBarrier { unsigned* bar; unsigned x; volatile LAS unsigned* st; };
DI XcdBarrier xcd_barrier_post(unsigned* bar, volatile LAS unsigned* st) {
    XcdBarrier b; b.bar = bar; b.x = xb_xcc_id(); b.st = st;
    if (threadIdx.x == 0) (void)xb_add(&bar[XB_XCNT(b.x)], 1u);
    return b;
}
DI void xcd_barrier_complete(unsigned* bar, unsigned x, unsigned& nloc, unsigned& nx) {
    const unsigned G = gridDim.x * gridDim.y * gridDim.z;
    unsigned sum, cnt, mine, sp = 0u;
    for (;;) {
        sum = 0u; cnt = 0u; mine = 0u;
#pragma unroll
        for (unsigned j = 0; j < 16; ++j) { const unsigned c = xb_ld(&bar[XB_XCNT(j)]); sum += c; cnt += (c > 0u) ? 1u : 0u; mine = (j == x) ? c : mine; }
        if (sum == G) break;
        __builtin_amdgcn_s_sleep(1);
        if ((++sp & 255u) == 0u) { if (xb_ld(&bar[XB_TMO])) break; if (sp > XB_SPIN_CAP) { atomicAdd(&bar[XB_TMO], 1u); break; } }
    }
    nloc = mine > 0u ? mine : 1u; nx = cnt > 0u ? cnt : 1u;
}
DI void xcd_barrier(const XcdBarrier& b) {
    asm volatile("s_waitcnt vmcnt(0)" ::: "memory");
    __syncthreads();
    if (threadIdx.x == 0) {
        unsigned* bar = b.bar;
        __builtin_amdgcn_s_waitcnt(0);
        unsigned nloc = b.st[0], nx = b.st[1];
        if (nloc == 0u) { xcd_barrier_complete(bar, b.x, nloc, nx); b.st[0] = nloc; b.st[1] = nx; }
        const unsigned old = xb_add(&bar[XB_XSUB(b.x)], 1u);
        const unsigned gen = old / nloc;
        if (old + 1u == (gen + 1u) * nloc) {
            __builtin_amdgcn_fence(__ATOMIC_RELEASE, "agent");
            asm volatile("s_waitcnt vmcnt(0)" ::: "memory");
            const unsigned og = xb_add(&bar[XB_TOP], 1u);
            const unsigned tg = og / nx;
            if (og + 1u == (tg + 1u) * nx) xb_add(&bar[XB_TOPGEN], 1u);
            else XB_SPIN(xb_ld(&bar[XB_TOPGEN]) == tg, bar);
            __builtin_amdgcn_fence(__ATOMIC_ACQUIRE, "agent");
            xb_add(&bar[XB_XGEN(b.x)], 1u);
            asm volatile("s_waitcnt vmcnt(0)" ::: "memory");
        } else {
            XB_SPIN(xb_ld(&bar[XB_XGEN(b.x)]) == gen, bar);
            __builtin_amdgcn_fence(__ATOMIC_ACQUIRE, "agent");
            asm volatile("s_waitcnt vmcnt(0)" ::: "memory");
        }
    }
    __syncthreads();
}

template <class CMap> DI void p0_transpose_item(const float* W, int K, int ldw, bf16_t* WT, LAS float* scr, int item, int nblk, int lane, CMap cm) {
    const int kb = item / nblk, nb = item % nblk, k0 = 64 * kb, n0 = 32 * nb;
    const int col = cm(n0 + (lane & 31));
#pragma unroll 8
    for (int i = 0; i < 32; ++i) { const int kk = 2 * i + (lane >> 5); scr[kk * 33 + (lane & 31)] = (col >= 0) ? W[(size_t)(k0 + kk) * ldw + col] : 0.f; }
    LDS_WAIT(); asm volatile("" ::: "memory");
    const int c = lane & 7;
#pragma unroll
    for (int j = 0; j < 4; ++j) { const int n = (lane >> 3) + 8 * j; const LAS float* s = scr + (8 * c) * 33 + n;
        u32x4 o; o.x = cvtpk(s[0 * 33], s[1 * 33]); o.y = cvtpk(s[2 * 33], s[3 * 33]); o.z = cvtpk(s[4 * 33], s[5 * 33]); o.w = cvtpk(s[6 * 33], s[7 * 33]);
        *(u32x4*)(WT + (size_t)(n0 + n) * K + k0 + 8 * c) = o; }
    LDS_WAIT(); asm volatile("" ::: "memory");
}
template <bool OUTF> DI void rms_row(const float* xrow, const float* g, void* orow, int lane) {
    const f32x4* xr = (const f32x4*)xrow + lane; f32x4 v[8]; float s = 0.f;
#pragma unroll
    for (int j = 0; j < 8; ++j) { v[j] = xr[64 * j]; s += (v[j][0] * v[j][0] + v[j][1] * v[j][1]) + (v[j][2] * v[j][2] + v[j][3] * v[j][3]); }
    const float rstd = 1.0f / sqrtf(wave_sum(s) * (1.f / DM) + EPS);
#pragma unroll
    for (int j = 0; j < 8; ++j) { const f32x4 gv = ((const f32x4*)g)[lane + 64 * j]; const f32x4 o = v[j] * rstd * gv;
        if (OUTF) ((f32x4*)orow)[lane + 64 * j] = o;
        else ((u32x2*)orow)[lane + 64 * j] = (u32x2){cvtpk(o[0], o[1]), cvtpk(o[2], o[3])}; }
}
DI void rope_entry(float* CS, int idx) {
    const int p = idx >> 6, i = idx & 63; const float pos = (p == SEQ) ? (float)PAST : (float)p;
    const float ang = pos * ROPE_INV[i];
    const double a = (double)ang, q = __builtin_rint(a * 0.63661977236758134308);
    double r = __builtin_fma(-q, 1.57079632679489655800, a); r = __builtin_fma(-q, 6.12323399573676603587e-17, r);
    const double r2 = r * r;
    const double sp = r + r * r2 * (-1.0 / 6 + r2 * (1.0 / 120 + r2 * (-1.0 / 5040 + r2 * (1.0 / 362880 + r2 * (-1.0 / 39916800 + r2 * (1.0 / 6227020800.0))))));
    const double cp = 1.0 + r2 * (-0.5 + r2 * (1.0 / 24 + r2 * (-1.0 / 720 + r2 * (1.0 / 40320 + r2 * (-1.0 / 3628800 + r2 * (1.0 / 479001600.0 + r2 * (-1.0 / 87178291200.0)))))));
    const int n = (int)q & 3;
    const double c = (n == 0) ? cp : (n == 1) ? -sp : (n == 2) ? -cp : sp;
    const double s = (n == 0) ? sp : (n == 1) ? cp : (n == 2) ? -sp : -cp;
    CS[(size_t)p * 128 + i] = (float)c; CS[(size_t)p * 128 + 64 + i] = (float)s;
}
DI void p0_prologue(Frame& F) {
    LAS float* scr = (LAS float*)(F.lds + F.wave * 16384);
    const int gw = F.bid * NWAVES + F.wave, NGW = F.G * NWAVES;
    bf16_t* WT = (bf16_t*)(F.ws + WS_WT); bf16_t* WOT = (bf16_t*)(F.ws + WS_WOT); bf16_t* XN = (bf16_t*)(F.ws + WS_XN);
    constexpr int I_IN = (DM / 64) * (DINP / 32), I_OUT = (DM / 64) * (DM / 32);
    for (int it = gw; it < I_IN + I_OUT; it += NGW) {
        if (it < I_IN) p0_transpose_item(F.w_in, DM, DIN, WT, scr, it, DINP / 32, F.lane, [](int n) { return cmap_in(n); });
        else p0_transpose_item(F.w_out, DM, DM, WOT, scr, it - I_IN, DM / 32, F.lane, [](int n) { return n; });
    }
    for (int m = gw; m < MP; m += NGW) rms_row<false>(F.x + (size_t)m * DM, F.norm_g, XN + (size_t)m * DM, F.lane);
    if (F.bid == F.G - 1) rms_row<true>(F.xs + (size_t)F.wave * DM, F.norm_g, (float*)(F.ws + WS_XNS) + (size_t)F.wave * DM, F.lane);
    { const int gt = F.bid * NTHR + F.tid; float* CS = (float*)(F.ws + WS_CS);
      for (int idx = gt; idx < (SEQ + 1) * 64; idx += F.G * NTHR) rope_entry(CS, idx); }
}

DI void p1_sample_gemv(Frame& F) {
    LAS float* xs = (LAS float*)F.lds;
    const float* XNS = (const float*)(F.ws + WS_XNS);
    for (int i = F.tid; i < DB * DM / 4; i += NTHR) ((LAS f32x4*)xs)[i] = ((const f32x4*)XNS)[i];
    __syncthreads();
    const bf16_t* WT = (const bf16_t*)(F.ws + WS_WT); float* ZS = (float*)(F.ws + WS_ZS);
    const int gw = F.bid * NWAVES + F.wave, NGW = F.G * NWAVES, lane = F.lane;
    for (int n = gw; n < DIN; n += NGW) {
        asm volatile("" ::: "memory");
        const u32x4* wrow = (const u32x4*)(WT + (size_t)n * DM);
        float acc[8];
#pragma unroll
        for (int j = 0; j < 8; ++j) acc[j] = 0.f;
#pragma unroll
        for (int i = 0; i < 4; ++i) {
            const u32x4 w = wrow[lane + 64 * i];
            const float w0 = bflo(w.x), w1 = bfhi(w.x), w2 = bflo(w.y), w3 = bfhi(w.y), w4 = bflo(w.z), w5 = bfhi(w.z), w6 = bflo(w.w), w7 = bfhi(w.w);
#pragma unroll
            for (int j = 0; j < 8; ++j) {
                const LAS f32x4* xp = (const LAS f32x4*)(xs + j * DM + 8 * (lane + 64 * i));
                const f32x4 a = xp[0], b = xp[1];
                acc[j] += (a[0] * w0 + a[1] * w1) + (a[2] * w2 + a[3] * w3) + (b[0] * w4 + b[1] * w5) + (b[2] * w6 + b[3] * w7);
            }
        }
#pragma unroll
        for (int j = 0; j < 8; ++j) acc[j] = wave_sum(acc[j]);
        float r = acc[0];
#pragma unroll
        for (int j = 1; j < 8; ++j) r = (lane == j) ? acc[j] : r;
        if (lane < 8) ZS[(size_t)lane * DIN + cmap_in(n)] = r;
    }
    __syncthreads();
}

DI void p2_indexer_unit(Frame& F, int b, int j8) {
    LAS char* L = (LAS char*)F.lds;
    LAS char* KB0 = L;
    LAS char* KB1 = L + 32768;
    LAS float* SC = (LAS float*)(L + 65536);
    const int tid = F.tid, lane = F.lane, w = F.wave, wm = w & 3, wn = w >> 2, hh = lane >> 5;
    const int t0 = 8 * j8, R0 = b * SEQ + t0, NT = ((t0 + 7) >> 7) + 1;
    const bf16_t* QI = (const bf16_t*)(F.ws + WS_QI); const bf16_t* KI = (const bf16_t*)(F.ws + WS_KI); const float* WI = (const float*)(F.ws + WS_WI);
    load_tile<128, false>(KB1, (const char*)(QI + (size_t)R0 * 2048), 256, tid);
    load_tile<128, false>(KB0, (const char*)(KI + (size_t)b * SEQ * 128), 256, tid);
    __syncthreads();
    bf16x8 qf[8];
#pragma unroll
    for (int s = 0; s < 8; ++s) qf[s] = row_frag(KB1, 32 * wm, lane, s);
    float wv[16];
#pragma unroll
    for (int r = 0; r < 16; ++r) wv[r] = WI[(size_t)(R0 + 2 * wm + (r >> 3)) * 16 + (r & 3) + 8 * ((r >> 2) & 1) + 4 * hh];
    __syncthreads();
    for (int T = 0; T < NT; ++T) {
        LAS char* KB = (T & 1) ? KB1 : KB0;
        if (T + 1 < NT) load_tile<128, false>((T & 1) ? KB0 : KB1, (const char*)(KI + ((size_t)b * SEQ + 128 * (T + 1)) * 128), 256, tid);
#pragma unroll
        for (int nb = 0; nb < 2; ++nb) {
            f32x16 acc = zero16();
#pragma unroll
            for (int s = 0; s < 8; ++s) acc = MFMA32(qf[s], row_frag(KB, 64 * wn + 32 * nb, lane, s), acc);
            float p0 = 0.f, p1 = 0.f;
#pragma unroll
            for (int r = 0; r < 8; ++r) { p0 += wv[r] * fmaxf(acc[r], 0.f); p1 += wv[8 + r] * fmaxf(acc[8 + r], 0.f); }
            p0 += __shfl_xor(p0, 32); p1 += __shfl_xor(p1, 32);
            const int key = 128 * T + 64 * wn + 32 * nb + (lane & 31);
            SC[(2 * wm + hh) * 2048 + key] = hh ? p1 : p0;
        }
        __syncthreads();
    }
    const int t = t0 + w; unsigned u[32];
#pragma unroll
    for (int i = 0; i < 32; ++i) { const int k = 64 * i + lane; u[i] = (k <= t) ? fkey(SC[w * 2048 + k]) : 0u; }
    unsigned long long* MASK = (unsigned long long*)(F.ws + WS_MASK) + (size_t)(R0 + w) * 32;
    unsigned thr = 1u; int need_eq = 0; unsigned idx_cut = 0xffffffffu;
    bool all = (t + 1 <= TOPK);
    unsigned T_sel = 0u;
    bool tie = false;
    if (!all) {
        unsigned prefix = 0u; bool exact = false;
        for (int bit = 31; bit >= 0; --bit) {
            const unsigned cand = prefix | (1u << bit); int cnt = 0;
#pragma unroll
            for (int i = 0; i < 32; ++i) cnt += __popcll(__ballot(u[i] >= cand));
            if (cnt >= TOPK) prefix = cand;
            if (cnt == TOPK) { exact = true; break; }
        }
        T_sel = prefix;
        if (!exact) {
            int cgt = 0;
#pragma unroll
            for (int i = 0; i < 32; ++i) cgt += __popcll(__ballot(u[i] > prefix));
            need_eq = TOPK - cgt; tie = true;
            unsigned lo = 0u, hi = 2047u;
            while (lo < hi) { const unsigned mid = (lo + hi) >> 1; int c = 0;
#pragma unroll
                for (int i = 0; i < 32; ++i) c += __popcll(__ballot(u[i] == prefix && (unsigned)(64 * i + lane) <= mid));
                if (c >= need_eq) hi = mid; else lo = mid + 1u; }
            idx_cut = lo;
        }
    }
    (void)thr;
#pragma unroll
    for (int i = 0; i < 32; ++i) {
        const unsigned k = 64 * i + lane; bool sel;
        if (all) sel = (int)k <= t;
        else if (!tie) sel = u[i] >= T_sel;
        else sel = (u[i] > T_sel) || (u[i] == T_sel && k <= idx_cut);
        const unsigned long long m = __ballot(sel);
        if (lane == 0) MASK[i] = m;
    }
    __syncthreads();
}

DI void p2_retA_unit(Frame& F, int bh, int c) {
    LAS char* L = (LAS char*)F.lds; LAS char* KIMG = L; LAS char* VIMG = L + 32768;
    const int b = bh >> 3, h = bh & 7, R0 = b * SEQ + c * CH, lane = F.lane, w = F.wave, dt = w >> 1, eh = w & 1, hh = lane >> 5;
    const bf16_t* KR = (const bf16_t*)(F.ws + WS_KR); const bf16_t* VR = (const bf16_t*)(F.ws + WS_VR);
    load_tile<128, false>(KIMG, (const char*)(KR + (size_t)R0 * 1024 + h * 128), 2048, F.tid);
    load_tile<128, false>(VIMG, (const char*)(VR + (size_t)R0 * 1024 + h * 128), 2048, F.tid);
    __syncthreads();
    f32x16 acc[2] = {zero16(), zero16()};
#pragma unroll
    for (int ks = 0; ks < 8; ++ks) {
        const bf16x8 a = tr_frag(KIMG, 16 * ks, 32 * dt, lane);
#pragma unroll
        for (int e2 = 0; e2 < 2; ++e2) acc[e2] = MFMA32(a, tr_frag(VIMG, 16 * ks, 32 * (2 * eh + e2), lane), acc[e2]);
    }
    float* KV = (float*)(F.ws + WS_KV) + ((size_t)bh * NCH + c) * 16384;
#pragma unroll
    for (int e2 = 0; e2 < 2; ++e2)
#pragma unroll
        for (int r = 0; r < 16; ++r) KV[(32 * dt + crow(r, hh)) * 128 + 32 * (2 * eh + e2) + (lane & 31)] = acc[e2][r];
    __syncthreads();
}

DI void p2_sample_scores(Frame& F) {
    const int g = F.bid, b = g >> 5, lane = F.lane, key16 = lane & 15, gq = lane >> 4;
    const float* ZS = (const float*)(F.ws + WS_ZS) + (size_t)b * DIN;
    f32x4 qa[8];
#pragma unroll
    for (int t = 0; t < 8; ++t) qa[t] = *(const f32x4*)(ZS + C_QI + key16 * 128 + 16 * t + 4 * gq);
    float wv[4];
#pragma unroll
    for (int r = 0; r < 4; ++r) wv[r] = ZS[C_WI + 4 * gq + r] * WI_SCALE;
    float* SCS = (float*)(F.ws + WS_SCS) + (size_t)b * PAST;
    for (int grp = 0; grp < 4; ++grp) {
        const int s0 = 512 * (g & 31) + 64 * F.wave + 16 * grp, s = s0 + key16;
        const int page = F.ptab[b * NPAGES + (s >> 7)];
        const float* krow = F.cache_ki + ((size_t)page * PAGE + (s & 127)) * DIDX;
        f32x4 kb[8];
#pragma unroll
        for (int t = 0; t < 8; ++t) kb[t] = *(const f32x4*)(krow + 16 * t + 4 * gq);
        f32x4 acc = {0.f, 0.f, 0.f, 0.f};
#pragma unroll
        for (int t = 0; t < 8; ++t)
#pragma unroll
            for (int i = 0; i < 4; ++i) acc = __builtin_amdgcn_mfma_f32_16x16x4f32(qa[t][i], kb[t][i], acc, 0, 0, 0);
        float p = 0.f;
#pragma unroll
        for (int r = 0; r < 4; ++r) p += wv[r] * fmaxf(acc[r], 0.f);
        p += __shfl_xor(p, 16); p += __shfl_xor(p, 32);
        if (gq == 0) SCS[s] = p;
    }
}

DI void p2_sample_retention(Frame& F, int b, int h) {
    LAS float* LQ = (LAS float*)F.lds;
    LAS float* LK = LQ + 128; LAS float* LP = LQ + 256; LAS float* LO = LQ + 768;
    const float* ZS = (const float*)(F.ws + WS_ZS) + (size_t)b * DIN; const float* CS = (const float*)(F.ws + WS_CS) + (size_t)SEQ * 128;
    const int tid = F.tid;
    if (tid < 64) {
        const float c = CS[tid], s = CS[64 + tid];
        const float q1 = ZS[C_QR + h * 128 + tid], q2 = ZS[C_QR + h * 128 + 64 + tid], k1 = ZS[C_KR + h * 128 + tid], k2 = ZS[C_KR + h * 128 + 64 + tid];
        LQ[tid] = q1 * c - q2 * s; LQ[64 + tid] = q1 * s + q2 * c;
        LK[tid] = (k1 * c - k2 * s) * KSCALE; LK[64 + tid] = (k1 * s + k2 * c) * KSCALE;
    }
    __syncthreads();
    const int e = tid & 127, dq = tid >> 7; const float gam = 1.0f - __builtin_amdgcn_exp2f((float)(-5 - h));
    const float v = ZS[C_VR + h * 128 + e];
    const float* S = F.state + ((size_t)(b * NRH + h)) * 16384; float* SN = F.out + O_STS + ((size_t)(b * NRH + h)) * 16384;
    float part = 0.f;
#pragma unroll 8
    for (int dd = 0; dd < 32; ++dd) { const int d = 32 * dq + dd; const float sv = S[d * 128 + e]; part += LQ[d] * sv; SN[d * 128 + e] = gam * sv + LK[d] * v; }
    LP[dq * 128 + e] = part;
    __syncthreads();
    if (tid < 128) {
        float qk = 0.f;
#pragma unroll 8
        for (int d = 0; d < 128; ++d) qk += LQ[d] * LK[d];
        LO[tid] = qk * v + gam * ((LP[tid] + LP[128 + tid]) + (LP[256 + tid] + LP[384 + tid]));
    }
    __syncthreads();
    if (F.wave == 0) {
        const float o0 = LO[F.lane], o1 = LO[64 + F.lane];
        const float mu = wave_sum(o0 + o1) * (1.f / 128); const float d0 = o0 - mu, d1 = o1 - mu;
        const float rs = 1.0f / sqrtf(wave_sum(d0 * d0 + d1 * d1) * (1.f / 128) + EPS);
        float* ACTS = (float*)(F.ws + WS_ACTS) + (size_t)b * DM + h * 128;
        ACTS[F.lane] = d0 * rs * F.ret_g[h * 128 + F.lane] * silu(ZS[C_GR + h * 128 + F.lane]);
        ACTS[64 + F.lane] = d1 * rs * F.ret_g[h * 128 + 64 + F.lane] * silu(ZS[C_GR + h * 128 + 64 + F.lane]);
    }
    __syncthreads();
}

DI void p3_scan(Frame& F) {
    const int gt = F.bid * NTHR + F.tid;
    if (gt >= 32 * 4096) return;
    const int bh = gt >> 12, e4 = (gt & 4095) * 4, h = bh & 7;
    const float g128 = __builtin_amdgcn_exp2f(128.f * l2g(h));
    const float* KV = (const float*)(F.ws + WS_KV) + (size_t)bh * NCH * 16384 + e4; bf16_t* SP = (bf16_t*)(F.ws + WS_SP) + (size_t)bh * NCH * 16384 + e4;
    f32x4 S = {0.f, 0.f, 0.f, 0.f};
#pragma unroll 4
    for (int c = 0; c < NCH; ++c) {
        S = (S + *(const f32x4*)(KV + (size_t)c * 16384)) * g128;
        if (c + 1 < NCH) *(u32x2*)(SP + (size_t)(c + 1) * 16384) = (u32x2){cvtpk(S[0], S[1]), cvtpk(S[2], S[3])};
    }
    *(f32x4*)(F.out + O_ST + (size_t)bh * 16384 + e4) = S;
}

DI void p3_sample_attend(Frame& F, int b) {
    LAS unsigned* LU = (LAS unsigned*)F.lds;
    LAS int* LIST = (LAS int*)(F.lds + 256);
    LAS float* LG = (LAS float*)(F.lds + 2048);
    LAS float* LQA = (LAS float*)(F.lds + 2048 + 8192);
    LAS float* LPO = (LAS float*)(F.lds + 2048 + 8192 + 4096);
    (void)LPO;
    const int tid = F.tid, lane = F.lane, w = F.wave;
    const float* ZS = (const float*)(F.ws + WS_ZS) + (size_t)b * DIN; const float* SCS = (const float*)(F.ws + WS_SCS) + (size_t)b * PAST;
    for (int i = tid; i < 1024; i += NTHR) LQA[i] = ZS[C_QA + i];
    if (w == 0) {
        const int hh = lane >> 2, qd = lane & 3; float p = 0.f;
#pragma unroll 8
        for (int d = 0; d < 32; ++d) p += ZS[C_QI + hh * 128 + 32 * qd + d] * ZS[C_KI + 32 * qd + d];
        p += __shfl_xor(p, 1); p += __shfl_xor(p, 2);
        float sc = ZS[C_WI + hh] * WI_SCALE * fmaxf(p, 0.f);
        sc += __shfl_xor(sc, 4); sc += __shfl_xor(sc, 8); sc += __shfl_xor(sc, 16); sc += __shfl_xor(sc, 32);
        if (lane == 0) LU[16] = fkey(sc);
    }
    __syncthreads();
    unsigned u[33];
#pragma unroll
    for (int i = 0; i < 32; ++i) u[i] = fkey(SCS[tid + 512 * i]);
    u[32] = (tid == 0) ? LU[16] : 0u;
    unsigned prefix = 0u; bool exact = false;
    for (int bit = 31; bit >= 0; --bit) {
        const unsigned cand = prefix | (1u << bit); int c = 0;
#pragma unroll
        for (int i = 0; i < 33; ++i) c += (u[i] >= cand) ? 1 : 0;
#pragma unroll
        for (int o = 1; o < 64; o <<= 1) c += __shfl_xor(c, o);
        if (lane == 0) LU[w] = (unsigned)c;
        __syncthreads();
        int tot = 0;
#pragma unroll
        for (int i = 0; i < 8; ++i) tot += (int)LU[i];
        __syncthreads();
        if (tot >= TOPK) prefix = cand;
        if (tot == TOPK) { exact = true; break; }
    }
    unsigned idx_cut = 0xffffffffu;
    if (!exact) {
        int c = 0;
#pragma unroll
        for (int i = 0; i < 33; ++i) c += (u[i] > prefix) ? 1 : 0;
#pragma unroll
        for (int o = 1; o < 64; o <<= 1) c += __shfl_xor(c, o);
        if (lane == 0) LU[w] = (unsigned)c;
        __syncthreads();
        int cgt = 0;
#pragma unroll
        for (int i = 0; i < 8; ++i) cgt += (int)LU[i];
        __syncthreads();
        const int need = TOPK - cgt; unsigned lo = 0u, hi = (unsigned)PAST;
        while (lo < hi) {
            const unsigned mid = (lo + hi) >> 1; int cc = 0;
#pragma unroll
            for (int i = 0; i < 33; ++i) cc += (u[i] == prefix && (unsigned)(tid + 512 * i) <= mid) ? 1 : 0;
#pragma unroll
            for (int o = 1; o < 64; o <<= 1) cc += __shfl_xor(cc, o);
            if (lane == 0) LU[w] = (unsigned)cc;
            __syncthreads();
            int tot = 0;
#pragma unroll
            for (int i = 0; i < 8; ++i) tot += (int)LU[i];
            __syncthreads();
            if (tot >= need) hi = mid; else lo = mid + 1u;
        }
        idx_cut = lo;
    }
    int mycnt = 0;
#pragma unroll
    for (int i = 0; i < 33; ++i) { const bool sel = exact ? (u[i] >= prefix && u[i] != 0u) : ((u[i] > prefix) || (u[i] == prefix && (unsigned)(tid + 512 * i) <= idx_cut)); mycnt += __popcll(__ballot(sel)); }
    if (lane == 0) LU[w] = (unsigned)mycnt;
    __syncthreads();
    int base = 0;
#pragma unroll
    for (int i = 0; i < 8; ++i) base += (i < w) ? (int)LU[i] : 0;
#pragma unroll
    for (int i = 0; i < 33; ++i) {
        const bool sel = exact ? (u[i] >= prefix && u[i] != 0u) : ((u[i] > prefix) || (u[i] == prefix && (unsigned)(tid + 512 * i) <= idx_cut));
        const unsigned long long m = __ballot(sel);
        if (sel) { const int pos = base + __popcll(m & ((1ull << lane) - 1ull)); if (pos < TOPK) LIST[pos] = tid + 512 * i; }
        base += __popcll(m);
    }
    __syncthreads();
    {
        const int kk = tid >> 1, c = tid & 1, idx = LIST[kk];
        const float* krow;
        if (idx < PAST) { const int page = F.ptab[b * NPAGES + (idx >> 7)]; krow = F.cache_k + (((size_t)page * PAGE + (idx & 127)) * NKV + c) * HD; }
        else krow = ZS + C_KA + c * HD;
        float a0 = 0.f, a1 = 0.f, a2 = 0.f, a3 = 0.f;
        const LAS float* q = LQA + (4 * c) * 128;
#pragma unroll 4
        for (int d4 = 0; d4 < 32; ++d4) {
            const f32x4 kv = *(const f32x4*)(krow + 4 * d4);
            const f32x4 q0 = *(const LAS f32x4*)(q + 4 * d4), q1 = *(const LAS f32x4*)(q + 128 + 4 * d4), q2 = *(const LAS f32x4*)(q + 256 + 4 * d4), q3 = *(const LAS f32x4*)(q + 384 + 4 * d4);
            a0 += (kv[0] * q0[0] + kv[1] * q0[1]) + (kv[2] * q0[2] + kv[3] * q0[3]);
            a1 += (kv[0] * q1[0] + kv[1] * q1[1]) + (kv[2] * q1[2] + kv[3] * q1[3]);
            a2 += (kv[0] * q2[0] + kv[1] * q2[1]) + (kv[2] * q2[2] + kv[3] * q2[3]);
            a3 += (kv[0] * q3[0] + kv[1] * q3[1]) + (kv[2] * q3[2] + kv[3] * q3[3]);
        }
        LG[(4 * c + 0) * 256 + kk] = a0 * KSCALE; LG[(4 * c + 1) * 256 + kk] = a1 * KSCALE; LG[(4 * c + 2) * 256 + kk] = a2 * KSCALE; LG[(4 * c + 3) * 256 + kk] = a3 * KSCALE;
    }
    __syncthreads();
    {
        float l[4]; float mx = -3.0e38f;
#pragma unroll
        for (int i = 0; i < 4; ++i) { l[i] = LG[w * 256 + lane + 64 * i]; mx = fmaxf(mx, l[i]); }
#pragma unroll
        for (int o = 1; o < 64; o <<= 1) mx = fmaxf(mx, __shfl_xor(mx, o));
        float sum = 0.f;
#pragma unroll
        for (int i = 0; i < 4; ++i) { l[i] = __expf(l[i] - mx); sum += l[i]; }
        sum = wave_sum(sum); const float inv = 1.0f / sum;
#pragma unroll
        for (int i = 0; i < 4; ++i) LG[w * 256 + lane + 64 * i] = l[i] * inv;
    }
    __syncthreads();
    {
        const int c = w >> 2; float o0 = 0.f, o1 = 0.f;
        for (int kk = 0; kk < TOPK; ++kk) {
            const int idx = LIST[kk]; const float* vrow;
            if (idx < PAST) { const int page = F.ptab[b * NPAGES + (idx >> 7)]; vrow = F.cache_v + (((size_t)page * PAGE + (idx & 127)) * NKV + c) * HD; }
            else vrow = ZS + C_VA + c * HD;
            const f32x2 vv = *(const f32x2*)(vrow + 2 * lane); const float p = LG[w * 256 + kk];
            o0 += p * vv[0]; o1 += p * vv[1];
        }
        float* ACTS = (float*)(F.ws + WS_ACTS) + (size_t)b * DM + 1024 + w * 128 + 2 * lane;
        ACTS[0] = o0 * silu(ZS[C_GA + w * 128 + 2 * lane]); ACTS[1] = o1 * silu(ZS[C_GA + w * 128 + 2 * lane + 1]);
    }
    __syncthreads();
}

DI void p4_attn_unit(Frame& F, int b, int j16) {
    LAS char* L = (LAS char*)F.lds; LAS char* KIMG = L; LAS char* VIMG = L + 32768;
    const int tid = F.tid, lane = F.lane, w = F.wave, c = w >> 2, q16 = lane & 15, g = lane >> 4;
    const int t0 = 16 * j16, R0 = b * SEQ + t0, NT = (t0 >> 6) + 1;
    const bf16_t* QA = (const bf16_t*)(F.ws + WS_QA); const bf16_t* KA = (const bf16_t*)(F.ws + WS_KA); const bf16_t* VA = (const bf16_t*)(F.ws + WS_VA);
    const unsigned long long* MASK = (const unsigned long long*)(F.ws + WS_MASK) + (size_t)(R0 + q16) * 32;
    bf16x8 qf[4];
#pragma unroll
    for (int s = 0; s < 4; ++s) qf[s] = *(const bf16x8*)(QA + (size_t)(R0 + q16) * 1024 + w * 128 + 32 * s + 8 * g);
    f32x4 ot[8];
#pragma unroll
    for (int i = 0; i < 8; ++i) ot[i] = (f32x4){0.f, 0.f, 0.f, 0.f};
    float mrun = -1.0e30f, lrun = 0.f;
    for (int T = 0; T < NT; ++T) {
        __syncthreads();
        {
            const char* kg = (const char*)(KA + ((size_t)b * SEQ + 64 * T) * 256); const char* vg = (const char*)(VA + ((size_t)b * SEQ + 64 * T) * 256);
#pragma unroll
            for (int i = 0; i < 4; ++i) {
                const int n = tid + 512 * i, row = n >> 5, cc = (n >> 4) & 1, ch = n & 15;
                const u32x4 kv = *(const u32x4*)(kg + (size_t)row * 512 + cc * 256 + ch * 16), vv = *(const u32x4*)(vg + (size_t)row * 512 + cc * 256 + ch * 16);
                *(LAS u32x4*)(KIMG + cc * 16384 + tile_off(row, ch)) = kv; *(LAS u32x4*)(VIMG + cc * 16384 + vtile_off(row, ch)) = vv;
            }
        }
        __syncthreads();
        const unsigned long long mw = MASK[T] >> (4 * g);
        const unsigned mlo = (unsigned)mw, mhi = (unsigned)(mw >> 32);
        f32x4 st[4];
#pragma unroll
        for (int kb = 0; kb < 4; ++kb) {
            st[kb] = (f32x4){0.f, 0.f, 0.f, 0.f};
#pragma unroll
            for (int s = 0; s < 4; ++s) st[kb] = MFMA16(row_frag16(KIMG + c * 16384, 16 * kb, lane, s), qf[s], st[kb]);
        }
        float mt = -1.0e30f;
#pragma unroll
        for (int kb = 0; kb < 4; ++kb)
#pragma unroll
            for (int r = 0; r < 4; ++r) { const unsigned bit = ((kb < 2 ? mlo : mhi) >> (16 * (kb & 1) + r)) & 1u; st[kb][r] = bit ? st[kb][r] : -1.0e30f; mt = fmaxf(mt, st[kb][r]); }
        mt = fmaxf(mt, __shfl_xor(mt, 16)); mt = fmaxf(mt, __shfl_xor(mt, 32));
        const float mnew = fmaxf(mrun, mt), alpha = __builtin_amdgcn_exp2f(mrun - mnew);
        mrun = mnew; lrun *= alpha;
#pragma unroll
        for (int i = 0; i < 8; ++i) ot[i] = ot[i] * alpha;
        float ps = 0.f;
#pragma unroll
        for (int kb = 0; kb < 4; ++kb)
#pragma unroll
            for (int r = 0; r < 4; ++r) { const float p = (st[kb][r] > -0.5e30f) ? __builtin_amdgcn_exp2f(st[kb][r] - mnew) : 0.f; st[kb][r] = p; ps += p; }
        lrun += ps;
#pragma unroll
        for (int ks = 0; ks < 2; ++ks) {
            const u32x4 pw = {cvtpk(st[2 * ks][0], st[2 * ks][1]), cvtpk(st[2 * ks][2], st[2 * ks][3]), cvtpk(st[2 * ks + 1][0], st[2 * ks + 1][1]), cvtpk(st[2 * ks + 1][2], st[2 * ks + 1][3])};
            const bf16x8 pb = __builtin_bit_cast(bf16x8, pw);
#pragma unroll
            for (int c8 = 0; c8 < 8; ++c8) ot[c8] = MFMA16(tr16_perm(VIMG + c * 16384, 32 * ks, c8, lane), pb, ot[c8]);
        }
    }
    lrun += __shfl_xor(lrun, 16); lrun += __shfl_xor(lrun, 32);
    const float inv = 1.0f / lrun;
    const bf16_t* GA = (const bf16_t*)(F.ws + WS_GA) + (size_t)(R0 + q16) * 1024 + w * 128; bf16_t* ACT = (bf16_t*)(F.ws + WS_ACT) + (size_t)(R0 + q16) * DM + 1024 + w * 128;
#pragma unroll
    for (int c8 = 0; c8 < 8; ++c8) {
        const int d = 16 * c8 + 4 * g; const u32x2 gw = *(const u32x2*)(GA + d);
        const float o0 = ot[c8][0] * inv * bflo(gw.x), o1 = ot[c8][1] * inv * bfhi(gw.x), o2 = ot[c8][2] * inv * bflo(gw.y), o3 = ot[c8][3] * inv * bfhi(gw.y);
        *(u32x2*)(ACT + d) = (u32x2){cvtpk(o0, o1), cvtpk(o2, o3)};
    }
}

DI void p4_retB_unit(Frame& F, int bh, int c) {
    LAS char* L = (LAS char*)F.lds; LAS char* QIMG = L; LAS char* KIMG = L + 32768; LAS char* VIMG = L + 65536; LAS char* SIMG = L + 98304;
    LAS float* OUT = (LAS float*)L;
    const int b = bh >> 3, h = bh & 7, R0 = b * SEQ + c * CH, tid = F.tid, lane = F.lane, w = F.wave, it = w >> 1, eh = w & 1, hh = lane >> 5;
    const bf16_t* QR = (const bf16_t*)(F.ws + WS_QR); const bf16_t* KR = (const bf16_t*)(F.ws + WS_KR); const bf16_t* VR = (const bf16_t*)(F.ws + WS_VR);
    __syncthreads();
    load_tile<128, false>(QIMG, (const char*)(QR + (size_t)R0 * 1024 + h * 128), 2048, tid);
    load_tile<128, false>(KIMG, (const char*)(KR + (size_t)R0 * 1024 + h * 128), 2048, tid);
    load_tile<128, false>(VIMG, (const char*)(VR + (size_t)R0 * 1024 + h * 128), 2048, tid);
    if (c > 0) load_tile<128, false>(SIMG, (const char*)((const bf16_t*)(F.ws + WS_SP) + ((size_t)bh * NCH + c) * 16384), 256, tid);
    __syncthreads();
    f32x16 acc[2] = {zero16(), zero16()};
    bf16x8 qf[8];
#pragma unroll
    for (int s = 0; s < 8; ++s) qf[s] = row_frag(QIMG, 32 * it, lane, s);
    if (c > 0) {
#pragma unroll
        for (int s = 0; s < 8; ++s)
#pragma unroll
            for (int e2 = 0; e2 < 2; ++e2) acc[e2] = MFMA32(qf[s], tr_frag(SIMG, 16 * s, 32 * (2 * eh + e2), lane), acc[e2]);
    }
    for (int jt = 0; jt <= it; ++jt) {
        f32x16 X = zero16();
#pragma unroll
        for (int s = 0; s < 8; ++s) X = MFMA32(row_frag(KIMG, 32 * jt, lane, s), qf[s], X);
        if (jt == it) {
#pragma unroll
            for (int r = 0; r < 16; ++r) X[r] = (crow(r, hh) > (lane & 31)) ? 0.f : X[r];
        }
#pragma unroll
        for (int s2 = 0; s2 < 2; ++s2) {
            const u32x4 pw = {cvtpk(X[8 * s2 + 0], X[8 * s2 + 1]), cvtpk(X[8 * s2 + 2], X[8 * s2 + 3]), cvtpk(X[8 * s2 + 4], X[8 * s2 + 5]), cvtpk(X[8 * s2 + 6], X[8 * s2 + 7])};
            const bf16x8 xs = __builtin_bit_cast(bf16x8, pw);
#pragma unroll
            for (int e2 = 0; e2 < 2; ++e2) acc[e2] = MFMA32(xs, tr_frag_perm(VIMG, 32 * jt + 16 * s2, 32 * (2 * eh + e2), lane), acc[e2]);
        }
    }
    __syncthreads();
#pragma unroll
    for (int e2 = 0; e2 < 2; ++e2)
#pragma unroll
        for (int r = 0; r < 16; ++r) OUT[(32 * it + crow(r, hh)) * 129 + 32 * (2 * eh + e2) + (lane & 31)] = acc[e2][r];
    __syncthreads();
    {
        const int i = tid >> 2, qd = tid & 3; float v[32]; float s = 0.f;
#pragma unroll
        for (int e = 0; e < 32; ++e) { v[e] = OUT[i * 129 + 32 * qd + e]; s += v[e]; }
        s += __shfl_xor(s, 1); s += __shfl_xor(s, 2);
        const float mu = s * (1.f / 128); float q = 0.f;
#pragma unroll
        for (int e = 0; e < 32; ++e) { v[e] -= mu; q += v[e] * v[e]; }
        q += __shfl_xor(q, 1); q += __shfl_xor(q, 2);
        const float rs = 1.0f / sqrtf(q * (1.f / 128) + EPS);
        const bf16_t* GR = (const bf16_t*)(F.ws + WS_GR) + (size_t)(R0 + i) * 1024 + h * 128 + 32 * qd; bf16_t* ACT = (bf16_t*)(F.ws + WS_ACT) + (size_t)(R0 + i) * DM + h * 128 + 32 * qd;
        const float* rg = F.ret_g + h * 128 + 32 * qd;
#pragma unroll
        for (int e8 = 0; e8 < 4; ++e8) {
            const u32x4 gw = *(const u32x4*)(GR + 8 * e8); const f32x4 g0 = *(const f32x4*)(rg + 8 * e8), g1 = *(const f32x4*)(rg + 8 * e8 + 4);
            const float o0 = v[8 * e8 + 0] * rs * g0[0] * bflo(gw.x), o1 = v[8 * e8 + 1] * rs * g0[1] * bfhi(gw.x), o2 = v[8 * e8 + 2] * rs * g0[2] * bflo(gw.y), o3 = v[8 * e8 + 3] * rs * g0[3] * bfhi(gw.y);
            const float o4 = v[8 * e8 + 4] * rs * g1[0] * bflo(gw.z), o5 = v[8 * e8 + 5] * rs * g1[1] * bfhi(gw.z), o6 = v[8 * e8 + 6] * rs * g1[2] * bflo(gw.w), o7 = v[8 * e8 + 7] * rs * g1[3] * bfhi(gw.w);
            *(u32x4*)(ACT + 8 * e8) = (u32x4){cvtpk(o0, o1), cvtpk(o2, o3), cvtpk(o4, o5), cvtpk(o6, o7)};
        }
    }
    __syncthreads();
}

DI void p5_sample_outproj(Frame& F) {
    LAS float* xs = (LAS float*)F.lds;
    const float* ACTS = (const float*)(F.ws + WS_ACTS);
    for (int i = F.tid; i < DB * DM / 4; i += NTHR) ((LAS f32x4*)xs)[i] = ((const f32x4*)ACTS)[i];
    __syncthreads();
    const bf16_t* WOT = (const bf16_t*)(F.ws + WS_WOT);
    const int gw = F.bid * NWAVES + F.wave, NGW = F.G * NWAVES, lane = F.lane;
    for (int n = gw; n < DM; n += NGW) {
        asm volatile("" ::: "memory");
        const u32x4* wrow = (const u32x4*)(WOT + (size_t)n * DM);
        float acc[8];
#pragma unroll
        for (int j = 0; j < 8; ++j) acc[j] = 0.f;
#pragma unroll
        for (int i = 0; i < 4; ++i) {
            const u32x4 w = wrow[lane + 64 * i];
            const float w0 = bflo(w.x), w1 = bfhi(w.x), w2 = bflo(w.y), w3 = bfhi(w.y), w4 = bflo(w.z), w5 = bfhi(w.z), w6 = bflo(w.w), w7 = bfhi(w.w);
#pragma unroll
            for (int j = 0; j < 8; ++j) {
                const LAS f32x4* xp = (const LAS f32x4*)(xs + j * DM + 8 * (lane + 64 * i));
                const f32x4 a = xp[0], b = xp[1];
                acc[j] += (a[0] * w0 + a[1] * w1) + (a[2] * w2 + a[3] * w3) + (b[0] * w4 + b[1] * w5) + (b[2] * w6 + b[3] * w7);
            }
        }
#pragma unroll
        for (int j = 0; j < 8; ++j) acc[j] = wave_sum(acc[j]);
        float r = acc[0];
#pragma unroll
        for (int j = 1; j < 8; ++j) r = (lane == j) ? acc[j] : r;
        if (lane < 8) F.out[O_YS + (size_t)lane * DM + n] = F.xs[(size_t)lane * DM + n] + r;
    }
    __syncthreads();
}

DI void p6_final_norm(Frame& F) {
    const int gw = F.bid * NWAVES + F.wave, NGW = F.G * NWAVES, lane = F.lane;
    const float* PART = (const float*)(F.ws + WS_PART);
    for (int m = gw; m < MP; m += NGW) {
        float ss = (lane < 32) ? PART[(size_t)m * 32 + lane] : 0.f;
        ss = wave_sum(ss);
        const float rstd = 1.0f / sqrtf(ss * (1.f / DM) + EPS);
        f32x4* y = (f32x4*)(F.out + O_Y + (size_t)m * DM);
#pragma unroll
        for (int j = 0; j < 8; ++j) { const f32x4 gv = ((const f32x4*)F.fin_g)[lane + 64 * j]; y[lane + 64 * j] = y[lane + 64 * j] * rstd * gv; }
    }
    if (F.bid == F.G - 1) rms_row<true>(F.out + O_YS + (size_t)F.wave * DM, F.fin_g, F.out + O_YS + (size_t)F.wave * DM, lane);
}

constexpr int NPHASE = 7;
struct Args { const void* in[12]; float* out; unsigned char* ws; int ph_lo, ph_hi; };
__global__ void __launch_bounds__(NTHR, 2) hymba_fwd(Args args) {
    extern __shared__ __attribute__((aligned(16))) unsigned char lds_raw[];
    Frame F;
    F.lds = (LAS unsigned char*)lds_raw; F.MISC = (volatile LAS unsigned*)(F.lds + MISC_OFF);
    F.tid = threadIdx.x; F.lane = F.tid & 63; F.wave = __builtin_amdgcn_readfirstlane(F.tid >> 6); F.G = gridDim.x; F.bid = blockIdx.x;
    F.x = (const float*)args.in[0]; F.xs = (const float*)args.in[1]; F.cache_k = (const float*)args.in[2]; F.cache_v = (const float*)args.in[3]; F.cache_ki = (const float*)args.in[4];
    F.state = (const float*)args.in[5]; F.ptab = (const int*)args.in[6]; F.norm_g = (const float*)args.in[7]; F.w_in = (const float*)args.in[8]; F.ret_g = (const float*)args.in[9];
    F.w_out = (const float*)args.in[10]; F.fin_g = (const float*)args.in[11]; F.out = args.out; F.ws = args.ws; F.ctl = (unsigned*)(args.ws + WS_CTL);
    for (int u = F.tid; u < (LDS_BYTES - RING_BYTES) / 4; u += NTHR) ((LAS unsigned*)(F.lds + RING_BYTES))[u] = 0u;
    __syncthreads();
    const int lo = args.ph_lo, hi = args.ph_hi;
    const bool use_bar = (hi - lo) > 1;
    XcdBarrier bar; bar.bar = F.ctl + CW_BAR; bar.x = 0; bar.st = nullptr;
    if (use_bar) bar = xcd_barrier_post(F.ctl + CW_BAR, F.MISC + 8);
#ifndef PHASE_MASK
#define PHASE_MASK 0x7f
#endif
#define IN(k) (((PHASE_MASK >> (k)) & 1) && lo <= (k) && (k) < hi)
#define SEAM(k) do { if (IN(k) && IN((k) + 1)) xcd_barrier(bar); } while (0)
    const int g = F.bid;
    if (IN(0)) { p0_prologue(F); SEAM(0); }
    if (IN(1)) {
        p1_sample_gemv(F);
        pg8::Gemm gm{(const bf16_t*)(F.ws + WS_XN), (const bf16_t*)(F.ws + WS_WT), MP, DINP, DM}; pg8::StaticOrder S; S.init(MP, DINP, F.G, g);
        EpiInProj E{(bf16_t*)(F.ws + WS_QR), (bf16_t*)(F.ws + WS_KR), (bf16_t*)(F.ws + WS_VR), (bf16_t*)(F.ws + WS_GR), (bf16_t*)(F.ws + WS_QA), (bf16_t*)(F.ws + WS_KA), (bf16_t*)(F.ws + WS_VA),
                    (bf16_t*)(F.ws + WS_GA), (bf16_t*)(F.ws + WS_QI), (bf16_t*)(F.ws + WS_KI), (float*)(F.ws + WS_WI), F.out + O_NK, F.out + O_NV, F.out + O_NKI, (const float*)(F.ws + WS_CS)};
        pg8::gemm_phase<EpiInProj, pg8::StaticOrder, true, true>(F.lds, gm, S, E);
        SEAM(1);
    }
    if (IN(2)) {
        if (g == 64) { const float* ZS = (const float*)(F.ws + WS_ZS);
            for (int i = F.tid; i < DB * 256; i += NTHR) { const int b = i >> 8, k = i & 255; F.out[O_NKS + i] = ZS[(size_t)b * DIN + C_KA + k]; F.out[O_NVS + i] = ZS[(size_t)b * DIN + C_VA + k]; }
            for (int i = F.tid; i < DB * 128; i += NTHR) { const int b = i >> 7, k = i & 127; F.out[O_NKIS + i] = ZS[(size_t)b * DIN + C_KI + k]; } }
        p2_sample_scores(F);
        if (g < 64) p2_sample_retention(F, g >> 3, g & 7);
        __syncthreads();
        for (int u = g; u < 512; u += F.G) p2_retA_unit(F, u >> 4, u & 15);
        for (int bq = 0; bq < NB; ++bq) { const int j = (bq & 1) ? (255 - (g & 255)) : (g & 255); if (g < 256) p2_indexer_unit(F, bq, j); }
        SEAM(2);
    }
    if (IN(3)) {
        if (g < DB) p3_sample_attend(F, g);
        p3_scan(F);
        SEAM(3);
    }
    if (IN(4)) {
        for (int u = g; u < 512; u += F.G) p4_retB_unit(F, u >> 4, u & 15);
        if (g < 256) { const int b = g >> 6, jj = g & 63; p4_attn_unit(F, b, jj); p4_attn_unit(F, b, 127 - jj); }
        SEAM(4);
    }
    if (IN(5)) {
        p5_sample_outproj(F);
        pg8::Gemm gm{(const bf16_t*)(F.ws + WS_ACT), (const bf16_t*)(F.ws + WS_WOT), MP, DM, DM}; pg8::StaticOrder S; S.init(MP, DM, F.G, g);
        EpiOutProj E{F.x, F.out + O_Y, (float*)(F.ws + WS_PART)};
        pg8::gemm_phase<EpiOutProj, pg8::StaticOrder, false, true>(F.lds, gm, S, E);
        SEAM(5);
    }
    if (IN(6)) p6_final_norm(F);
#undef IN
#undef SEAM
}

extern "C" void kernel_launch(void* const* d_in, const int* in_sizes, int n_in, void* d_out, int out_size, void* d_ws, size_t ws_size, hipStream_t stream) {
    static int grid = 0;
    if (grid == 0) {
        if (n_in != 12 || ws_size < WS_END) { fprintf(stderr, "kernel_launch: unexpected inputs (n_in %d, ws %zu)\n", n_in, ws_size); grid = -1; return; }
        if (hipFuncSetAttribute((const void*)hymba_fwd, hipFuncAttributeMaxDynamicSharedMemorySize, LDS_BYTES) != hipSuccess) { fprintf(stderr, "kernel_launch: hipFuncSetAttribute failed\n"); grid = -1; return; }
        int dev = 0, cus = 0, per_cu = 0;
        hipGetDevice(&dev); hipDeviceGetAttribute(&cus, hipDeviceAttributeMultiprocessorCount, dev);
        hipOccupancyMaxActiveBlocksPerMultiprocessor(&per_cu, (const void*)hymba_fwd, NTHR, LDS_BYTES);
        (void)hipGetLastError();
        if (per_cu < 1) fprintf(stderr, "kernel_launch: occupancy query reports %d blocks per CU\n", per_cu);
        grid = 256;
        if (cus < 256) fprintf(stderr, "kernel_launch: device has %d CUs; this kernel needs 256 co-resident workgroups\n", cus);
    }
    if (grid < 0) return;
    (void)hipMemsetAsync((char*)d_ws + WS_CTL, 0, CTL_ZERO_BYTES, stream);
    Args a{};
    for (int i = 0; i < 12; ++i) a.in[i] = d_in[i];
    a.out = (float*)d_out; a.ws = (unsigned char*)d_ws;
    if (MK_N_LAUNCHES == 1) {
        a.ph_lo = 0; a.ph_hi = NPHASE;
        hipLaunchKernelGGL(hymba_fwd, dim3(grid), dim3(NTHR), LDS_BYTES, stream, a);
    } else {
        for (int p = 0; p < NPHASE; ++p) { a.ph_lo = p; a.ph_hi = p + 1; hipLaunchKernelGGL(hymba_fwd, dim3(grid), dim3(NTHR), LDS_BYTES, stream, a); }
    }
}
```

```cpp
#include <hip/hip_runtime.h>
#include <cstdint>
#include <cstdio>

#define DI __device__ __forceinline__
#define LAS __attribute__((address_space(3)))
#define GAS __attribute__((address_space(1)))
typedef unsigned short bf16_t;
typedef short bf16x8 __attribute__((ext_vector_type(8)));
typedef short s16x4 __attribute__((ext_vector_type(4)));
typedef float f32x2 __attribute__((ext_vector_type(2)));
typedef float f32x4 __attribute__((ext_vector_type(4)));
typedef float f32x16 __attribute__((ext_vector_type(16)));
typedef unsigned u32x2 __attribute__((ext_vector_type(2)));
typedef unsigned u32x4 __attribute__((ext_vector_type(4)));
typedef __bf16 bf16x2_t __attribute__((ext_vector_type(2)));

#ifndef MK_N_LAUNCHES
#define MK_N_LAUNCHES 1
#endif

constexpr int DM = 2048, NB = 4, SEQ = 2048, MP = NB * SEQ  , DB = 8  , PAST = 16384, PAGE = 128, NPAGES = PAST / PAGE;
constexpr int HD = 128, NRH = 8, NAH = 8, NKV = 2, DKV = 256, NIH = 16, DIDX = 128, TOPK = 256, CH = 128  , NCH = SEQ / CH;
constexpr int DIN = 8848, DINP = 8960;
constexpr int C_QR = 0, C_KR = 1024, C_VR = 2048, C_GR = 3072, C_QA = 4096, C_KA = 5120, C_VA = 5376, C_GA = 5632, C_QI = 6656, C_KI = 8704, C_WI = 8832;
constexpr float EPS = 1e-6f;
constexpr float KSCALE = 0.08838834764831845f;
constexpr float QA_SCALE = 0.08838834764831845f * 1.4426950408889634f;
constexpr float WI_SCALE = 0.022097086912079608f;
constexpr size_t O_Y = 0, O_YS = 16777216, O_NK = 16793600, O_NV = 18890752, O_NKI = 20987904, O_ST = 22036480, O_NKS = 22560768, O_NVS = 22562816, O_NKIS = 22564864, O_STS = 22565888;
constexpr size_t MiB = 1u << 20;
constexpr size_t WS_CTL = 0, CTL_ZERO_BYTES = 1 * MiB;
constexpr size_t WS_WT = 2 * MiB;
constexpr size_t WS_WOT = 40 * MiB;
constexpr size_t WS_XN = 48 * MiB;
constexpr size_t WS_QR = 80 * MiB;
constexpr size_t WS_KR = 96 * MiB, WS_VR = 112 * MiB, WS_GR = 128 * MiB, WS_QA = 144 * MiB, WS_GA = 160 * MiB;
constexpr size_t WS_KA = 176 * MiB;
constexpr size_t WS_VA = 180 * MiB;
constexpr size_t WS_QI = 184 * MiB;
constexpr size_t WS_KI = 216 * MiB;
constexpr size_t WS_WI = 218 * MiB;
constexpr size_t WS_CS = 219 * MiB;
constexpr size_t WS_XNS = 221 * MiB;
constexpr size_t WS_ZS = 222 * MiB;
constexpr size_t WS_ACTS = 223 * MiB;
constexpr size_t WS_SCS = 224 * MiB;
constexpr size_t WS_PART = 225 * MiB;
constexpr size_t WS_MASK = 226 * MiB;
constexpr size_t WS_KV = 228 * MiB;
constexpr size_t WS_SP = 260 * MiB;
constexpr size_t WS_ACT = 276 * MiB;
constexpr size_t WS_END = 308 * MiB;

__device__ const float ROPE_INV[64] = {
1.f, 0.865964353f, 0.749894261f, 0.649381638f, 0.562341332f, 0.486967534f, 0.421696514f, 0.365174115f, 0.316227764f, 0.273841977f, 0.237137377f, 0.2053525f, 0.177827939f, 0.153992653f, 0.133352131f, 0.115478203f,
0.100000001f, 0.0865964293f, 0.0749894157f, 0.0649381652f, 0.0562341325f, 0.0486967526f, 0.0421696529f, 0.0365174115f, 0.0316227749f, 0.0273841973f, 0.0237137377f, 0.0205352511f, 0.0177827943f, 0.0153992651f, 0.0133352149f, 0.0115478206f,
0.00999999978f, 0.00865964312f, 0.00749894185f, 0.00649381615f, 0.00562341325f, 0.00486967526f, 0.00421696482f, 0.00365174119f, 0.00316227763f, 0.00273841969f, 0.00237137359f, 0.00205352483f, 0.00177827943f, 0.00153992651f, 0.00133352145f, 0.0011547819f,
0.00100000005f, 0.000865964335f, 0.000749894243f, 0.000649381662f, 0.000562341302f, 0.000486967532f, 0.000421696517f, 0.000365174143f, 0.000316227757f, 0.000273841957f, 0.00023713737f, 0.00020535251f, 0.00017782794f, 0.000153992645f, 0.00013335215f, 0.0001154782f};
DI float l2g(int h) {
    const float t[8] = {-0.04580368961312479f, -0.02272007650008353f, -0.011315313227834146f, -0.005646563141142063f, -0.0028205190623786626f, -0.0014095702546713536f, -0.0007046129765893727f, -0.0003522634716290214f};
    float r = t[0];
#pragma unroll
    for (int i = 1; i < 8; ++i) r = (h == i) ? t[i] : r;
    return r;
}

#define LDS_WAIT() asm volatile("s_waitcnt lgkmcnt(0)" ::: "memory")
#define VM_WAIT() asm volatile("s_waitcnt vmcnt(0)" ::: "memory")
DI unsigned cvtpk(float lo, float hi) { f32x2 v = {lo, hi}; bf16x2_t b = __builtin_convertvector(v, bf16x2_t); return __builtin_bit_cast(unsigned, b); }
DI float bf2f(unsigned short b) { return __uint_as_float((unsigned)b << 16); }
DI float bflo(unsigned w) { return __uint_as_float(w << 16); }
DI float bfhi(unsigned w) { return __uint_as_float(w & 0xffff0000u); }
DI float wave_sum(float v) {
#pragma unroll
    for (int o = 1; o < 64; o <<= 1) v += __shfl_xor(v, o);
    return v;
}
DI float silu(float x) { return x / (1.f + __expf(-x)); }
DI unsigned fkey(float s) { const unsigned b = __float_as_uint(s); return (b & 0x80000000u) ? ~b : (b | 0x80000000u); }

namespace pg8 {
constexpr int BM = 256, BK = 64, HALF = 128, HTB = HALF * BK * 2, STAGE_BYTES = 8 * HTB, NXCD = 8, WGM = 8;
DI int lds_byte(int r, int c) { const int st = (r >> 4) * 2 + (c >> 5), rr = r & 15, cc = c & 31, ob = rr * 64 + cc * 2; return st * 1024 + (ob ^ (((ob >> 9) & 1) << 5)); }
DI void stage_rc(int b, int& R, int& C) { const int st = b / 1024, sb = b % 1024, swz = sb ^ (((sb >> 9) & 1) << 5); R = (st >> 1) * 16 + swz / 64; C = (st & 1) * 32 + (swz % 64) / 2; }
DI int perm32(int rho) { const int n = rho >> 4, i = rho & 15; return 8 * (i >> 2) + 4 * n + (i & 3); }
struct Unit { int pm, pn; };
struct Gemm { const bf16_t* A; const bf16_t* Bt; int M, N, K; };
struct StaticOrder {
    int nM, nN, nwg, G, c;
    DI void init(int M, int N, int G_, int c_) { nM = M / BM; nN = N / BM; nwg = nM * nN; G = G_; c = c_; }
    DI bool next(int i, Unit& u) const {
        const long L = (long)i * G + c; if (L >= nwg) return false;
        int wgid = (int)L; { const int q = nwg / NXCD, r = nwg % NXCD, xcd = wgid % NXCD, off = wgid / NXCD; wgid = (xcd < r ? xcd * (q + 1) : r * (q + 1) + (xcd - r) * q) + off; }
        const int nig = WGM * nN, gid = wgid / nig, fm = gid * WGM, gsz = (nM - fm) < WGM ? (nM - fm) : WGM;
        u.pm = fm + ((wgid % nig) % gsz); u.pn = (wgid % nig) / gsz; return true;
    }
    DI void a_ready(const Unit&) const {}
    DI void done(const Unit&) const {}
};

template <class Epi, class Sched, bool ALIGN_EPI = false, bool SP2 = false>
DI void gemm_phase(LAS unsigned char* lds, const Gemm g, const Sched& S, const Epi& E) {
    const int tid = threadIdx.x, wid = __builtin_amdgcn_readfirstlane(tid >> 6), lane = tid & 63, wr = wid >> 2, wc = wid & 3, fr = lane & 15, fq = lane >> 4;
    const int K = g.K, nt = K / BK;
    unsigned voffA[2], voffB[2];
#pragma unroll
    for (int i = 0; i < 2; ++i) { int R, C; stage_rc(tid * 16 + i * 8192, R, C); const int Rb = Epi::PERM ? ((R & ~31) + perm32(R & 31)) : R;
        voffA[i] = (unsigned)(R * K + C) * 2u; voffB[i] = (unsigned)(Rb * K + C) * 2u; }
    const size_t kstep = (size_t)(BK * 2);
    const size_t hstep = (size_t)HALF * K * 2;
    const size_t tstep = 2 * hstep;
    const unsigned ldsw = (unsigned)wid * 1024u;
    const int aoff = lds_byte(wr * 64 + fr, fq * 8), boff = lds_byte(wc * 32 + fr, fq * 8);
#define PG8_SA(b, h) (((b) * 2 + (h)) * HTB)
#define PG8_SB(b, h) ((4 + (b) * 2 + (h)) * HTB)
#define PG8_STAGE(bufoff, gbase, voff) do { _Pragma("unroll") for (int _i = 0; _i < 2; ++_i) \
        __builtin_amdgcn_global_load_lds((const unsigned*)((const char*)(gbase) + (voff)[_i]), (LAS unsigned*)(lds + (bufoff) + ldsw + _i * 8192), 16, 0, 0); } while (0)
#define PG8_LDA(dst, b, h) do { _Pragma("unroll") for (int m = 0; m < 4; ++m) _Pragma("unroll") for (int k = 0; k < 2; ++k) dst[m][k] = *(const LAS bf16x8*)(lds + PG8_SA(b, h) + aoff + m * 2048 + k * 1024); } while (0)
#define PG8_LDB(dst, b, h) do { _Pragma("unroll") for (int n = 0; n < 2; ++n) _Pragma("unroll") for (int k = 0; k < 2; ++k) dst[n][k] = *(const LAS bf16x8*)(lds + PG8_SB(b, h) + boff + n * 2048 + k * 1024); } while (0)
#define PG8_MMA(ai, bj, At, Bt) do { __builtin_amdgcn_s_setprio(1); _Pragma("unroll") for (int m = 0; m < 4; ++m) _Pragma("unroll") for (int n = 0; n < 2; ++n) _Pragma("unroll") for (int k = 0; k < 2; ++k) \
        acc[ai][bj][m][n] = __builtin_amdgcn_mfma_f32_16x16x32_bf16(Bt[n][k], At[m][k], acc[ai][bj][m][n], 0, 0, 0); __builtin_amdgcn_s_setprio(0); } while (0)
#define PG8_WAIT_V(n) asm volatile("s_waitcnt vmcnt(" #n ")" ::: "memory")
#define PG8_WAIT_L(n) asm volatile("s_waitcnt lgkmcnt(" #n ")" ::: "memory")
#define PG8_BAR __builtin_amdgcn_s_barrier()
#define PG8_SCHED __builtin_amdgcn_sched_barrier(0)
    Unit cur, nxt; int ui = 0;
    if (!S.next(0, cur)) return;
    f32x4 acc[2][2][4][2];
#pragma unroll
    for (int a = 0; a < 2; ++a)
#pragma unroll
        for (int b = 0; b < 2; ++b)
#pragma unroll
            for (int m = 0; m < 4; ++m)
#pragma unroll
                for (int n = 0; n < 2; ++n) acc[a][b][m][n] = (f32x4){0.f, 0.f, 0.f, 0.f};
    bf16x8 At[4][2], B0[2][2], B1[2][2];
    const char* cA = (const char*)g.A + (size_t)cur.pm * tstep; const char* cB = (const char*)g.Bt + (size_t)cur.pn * tstep;
    S.a_ready(cur);
    if constexpr (SP2) {
        PG8_STAGE(PG8_SB(0, 0), cB, voffB); PG8_STAGE(PG8_SB(0, 1), cB + hstep, voffB); PG8_STAGE(PG8_SA(0, 0), cA, voffA); PG8_STAGE(PG8_SA(0, 1), cA + hstep, voffA);
        if (wr == 1) PG8_BAR;
        PG8_WAIT_V(2); PG8_BAR;
        PG8_STAGE(PG8_SB(1, 0), cB + kstep, voffB); PG8_STAGE(PG8_SA(1, 0), cA + kstep, voffA); PG8_STAGE(PG8_SB(1, 1), cB + hstep + kstep, voffB);
        PG8_WAIT_V(6); PG8_BAR;
    } else {
        PG8_STAGE(PG8_SB(0, 0), cB, voffB); PG8_STAGE(PG8_SA(0, 0), cA, voffA); PG8_STAGE(PG8_SB(0, 1), cB + hstep, voffB); PG8_STAGE(PG8_SA(0, 1), cA + hstep, voffA);
        if (wr == 1) PG8_BAR;
        PG8_WAIT_V(4); PG8_BAR;
        PG8_STAGE(PG8_SB(1, 0), cB + kstep, voffB); PG8_STAGE(PG8_SA(1, 0), cA + kstep, voffA); PG8_STAGE(PG8_SB(1, 1), cB + hstep + kstep, voffB);
        PG8_WAIT_V(6); PG8_BAR;
    }
    for (;;) {
        const bool has_next = S.next(ui + 1, nxt);
        const char* nA = has_next ? (const char*)g.A + (size_t)nxt.pm * tstep : cA; const char* nB = has_next ? (const char*)g.Bt + (size_t)nxt.pn * tstep : cB;
        for (int t = 0; t < nt; t += 2) {
            const bool last = (t == nt - 2);
            const char* a1 = cA + (size_t)(t + 1) * kstep;
            const char* a2 = last ? nA : cA + (size_t)(t + 2) * kstep; const char* b2 = last ? nB : cB + (size_t)(t + 2) * kstep;
            const char* a3 = a2 + kstep; const char* b3 = b2 + kstep;
            if (last && has_next) S.a_ready(nxt);
            if constexpr (SP2) {
            PG8_LDB(B0, 0, 0); PG8_LDB(B1, 0, 1); PG8_SCHED; PG8_LDA(At, 0, 0); PG8_STAGE(PG8_SA(1, 1), a1 + hstep, voffA);
            PG8_WAIT_V(8); PG8_WAIT_L(0); PG8_BAR; PG8_MMA(0, 0, At, B0); PG8_MMA(0, 1, At, B1); PG8_BAR; PG8_SCHED;
            PG8_LDA(At, 0, 1); PG8_STAGE(PG8_SB(0, 0), b2, voffB); PG8_STAGE(PG8_SB(0, 1), b2 + hstep, voffB); PG8_STAGE(PG8_SA(0, 0), a2, voffA);
            PG8_WAIT_V(8); PG8_WAIT_L(0); PG8_BAR; PG8_MMA(1, 0, At, B0); PG8_MMA(1, 1, At, B1); PG8_BAR; PG8_SCHED;
            PG8_LDB(B0, 1, 0); PG8_LDB(B1, 1, 1); PG8_SCHED; PG8_LDA(At, 1, 0); PG8_STAGE(PG8_SA(0, 1), a2 + hstep, voffA);
            PG8_WAIT_V(8); PG8_WAIT_L(0); PG8_BAR; PG8_MMA(0, 0, At, B0); PG8_MMA(0, 1, At, B1); PG8_BAR; PG8_SCHED;
            PG8_LDA(At, 1, 1); PG8_STAGE(PG8_SB(1, 0), b3, voffB); PG8_STAGE(PG8_SB(1, 1), b3 + hstep, voffB); PG8_STAGE(PG8_SA(1, 0), a3, voffA);
            PG8_WAIT_V(8); PG8_WAIT_L(0); PG8_BAR; PG8_MMA(1, 0, At, B0); PG8_MMA(1, 1, At, B1); PG8_BAR; PG8_SCHED;
            } else {
            PG8_LDB(B0, 0, 0); PG8_SCHED; PG8_LDA(At, 0, 0); PG8_STAGE(PG8_SA(1, 1), a1 + hstep, voffA);
            PG8_WAIT_L(8); PG8_BAR; PG8_WAIT_L(0); PG8_MMA(0, 0, At, B0); PG8_BAR; PG8_SCHED;
            PG8_LDB(B1, 0, 1); PG8_STAGE(PG8_SB(0, 0), b2, voffB);
            PG8_BAR; PG8_WAIT_L(0); PG8_MMA(0, 1, At, B1); PG8_BAR;
            PG8_LDA(At, 0, 1); PG8_STAGE(PG8_SA(0, 0), a2, voffA);
            PG8_BAR; PG8_WAIT_L(0); PG8_MMA(1, 0, At, B0); PG8_BAR; PG8_SCHED;
            PG8_STAGE(PG8_SB(0, 1), b2 + hstep, voffB);
            PG8_WAIT_V(6); PG8_BAR; PG8_MMA(1, 1, At, B1); PG8_BAR;
            PG8_LDB(B0, 1, 0); PG8_SCHED; PG8_LDA(At, 1, 0); PG8_STAGE(PG8_SA(0, 1), a2 + hstep, voffA);
            PG8_WAIT_L(8); PG8_BAR; PG8_WAIT_L(0); PG8_MMA(0, 0, At, B0); PG8_BAR; PG8_SCHED;
            PG8_LDB(B1, 1, 1); PG8_STAGE(PG8_SB(1, 0), b3, voffB);
            PG8_BAR; PG8_WAIT_L(0); PG8_MMA(0, 1, At, B1); PG8_BAR;
            PG8_LDA(At, 1, 1); PG8_STAGE(PG8_SA(1, 0), a3, voffA);
            PG8_BAR; PG8_WAIT_L(0); PG8_MMA(1, 0, At, B0); PG8_BAR; PG8_SCHED;
            PG8_STAGE(PG8_SB(1, 1), b3 + hstep, voffB);
            PG8_WAIT_V(6); PG8_BAR; PG8_MMA(1, 1, At, B1); PG8_BAR;
            }
        }
        if constexpr (ALIGN_EPI) { if (wr == 0) PG8_BAR; }
        if constexpr (!Epi::AFTER_DRAIN) { E(acc, cur, wr, wc, fr, fq); S.done(cur); }
        if (!has_next) break;
#pragma unroll
        for (int a = 0; a < 2; ++a)
#pragma unroll
            for (int b = 0; b < 2; ++b)
#pragma unroll
                for (int m = 0; m < 4; ++m)
#pragma unroll
                    for (int n = 0; n < 2; ++n) acc[a][b][m][n] = (f32x4){0.f, 0.f, 0.f, 0.f};
        cur = nxt; cA = nA; cB = nB; ++ui;
        if constexpr (ALIGN_EPI) { if (wr == 1) PG8_BAR; }
    }
    PG8_WAIT_V(0);
    if constexpr (!ALIGN_EPI) { if (wr == 0) PG8_BAR; }
    PG8_BAR;
#undef PG8_SA
#undef PG8_SB
#undef PG8_STAGE
#undef PG8_LDA
#undef PG8_LDB
#undef PG8_MMA
#undef PG8_WAIT_V
#undef PG8_WAIT_L
#undef PG8_BAR
#undef PG8_SCHED
}
}

DI int cmap_in(int c) {
    if (c >= DIN) return -1;
    if (c >= C_VR) return c;
    const int hb = c & ~127, s = c & 127, g = s >> 3, e = s & 7;
    return hb + ((e < 4) ? (4 * g + e) : (64 + 4 * g + (e - 4)));
}

struct EpiInProj {
    static constexpr bool PERM = true, AFTER_DRAIN = false;
    bf16_t *QR, *KR, *VR, *GR, *QA, *KA, *VA, *GA, *QI, *KI; float* WI; float *oK, *oV, *oKI; const float* CS;
    DI void operator()(const f32x4 (&acc)[2][2][4][2], const pg8::Unit& u, int wr, int wc, int fr, int fq) const {
        const int pn = u.pn, rowb = u.pm * 256 + wr * 64 + fr, cl = wc * 32 + 8 * fq;
        if (pn < 8) {
            const bool isq = pn < 4; bf16_t* dst = isq ? QR : KR; const int g4 = 4 * (4 * wc + fq);
#pragma unroll
            for (int ai = 0; ai < 2; ++ai)
#pragma unroll
                for (int m = 0; m < 4; ++m) {
                    const int row = rowb + ai * 128 + m * 16, pos = row & (SEQ - 1), ic = pos & (CH - 1);
                    const f32x4 cs = *(const f32x4*)(CS + (size_t)pos * 128 + g4), sn = *(const f32x4*)(CS + (size_t)pos * 128 + 64 + g4);
#pragma unroll
                    for (int bj = 0; bj < 2; ++bj) {
                        const int head = 2 * (pn & 3) + bj;
                        const float lg = l2g(head) * (float)(ic + 1);
                        const float sc = isq ? __builtin_amdgcn_exp2f(lg) : KSCALE * __builtin_amdgcn_exp2f(-lg);
                        const f32x4 x1 = acc[ai][bj][m][0], x2 = acc[ai][bj][m][1];
                        const f32x4 o1 = (x1 * cs - x2 * sn) * sc, o2 = (x1 * sn + x2 * cs) * sc;
                        bf16_t* p = dst + (size_t)row * 1024 + head * 128 + g4;
                        *(u32x2*)p = (u32x2){cvtpk(o1[0], o1[1]), cvtpk(o1[2], o1[3])};
                        *(u32x2*)(p + 64) = (u32x2){cvtpk(o2[0], o2[1]), cvtpk(o2[2], o2[3])};
                    }
                }
            return;
        }
        int kind; bf16_t* bdst = nullptr; int ld = 0, cbase = 0; float* fdst = nullptr; int fld = 0;
        if (pn < 12) { kind = 0; bdst = VR; ld = 1024; cbase = (pn - 8) * 256; }
        else if (pn < 16) { kind = 1; bdst = GR; ld = 1024; cbase = (pn - 12) * 256; }
        else if (pn < 20) { kind = 2; bdst = QA; ld = 1024; cbase = (pn - 16) * 256; }
        else if (pn == 20) { kind = 3; bdst = KA; ld = 256; cbase = 0; fdst = oK; fld = 256; }
        else if (pn == 21) { kind = 3; bdst = VA; ld = 256; cbase = 0; fdst = oV; fld = 256; }
        else if (pn < 26) { kind = 1; bdst = GA; ld = 1024; cbase = (pn - 22) * 256; }
        else if (pn < 34) { kind = 0; bdst = QI; ld = 2048; cbase = (pn - 26) * 256; }
        else { kind = 4; }
#pragma unroll
        for (int ai = 0; ai < 2; ++ai)
#pragma unroll
            for (int m = 0; m < 4; ++m) {
                const int row = rowb + ai * 128 + m * 16;
#pragma unroll
                for (int bj = 0; bj < 2; ++bj) {
                    f32x4 v0 = acc[ai][bj][m][0], v1 = acc[ai][bj][m][1];
                    const int col = bj * 128 + cl;
                    if (kind == 4) {
                        if (bj == 0) {
                            *(f32x4*)(oKI + (size_t)row * 128 + col) = v0; *(f32x4*)(oKI + (size_t)row * 128 + col + 4) = v1;
                            *(u32x4*)(KI + (size_t)row * 128 + col) = (u32x4){cvtpk(v0[0], v0[1]), cvtpk(v0[2], v0[3]), cvtpk(v1[0], v1[1]), cvtpk(v1[2], v1[3])};
                        } else if (cl < 16) {
                            *(f32x4*)(WI + (size_t)row * 16 + cl) = v0 * WI_SCALE; *(f32x4*)(WI + (size_t)row * 16 + cl + 4) = v1 * WI_SCALE;
                        }
                        continue;
                    }
                    if (kind == 3) { *(f32x4*)(fdst + (size_t)row * fld + col) = v0; *(f32x4*)(fdst + (size_t)row * fld + col + 4) = v1; }
                    if (kind == 1) {
#pragma unroll
                        for (int e = 0; e < 4; ++e) { v0[e] = silu(v0[e]); v1[e] = silu(v1[e]); }
                    }
                    if (kind == 2) { v0 = v0 * QA_SCALE; v1 = v1 * QA_SCALE; }
                    *(u32x4*)(bdst + (size_t)row * ld + cbase + col) = (u32x4){cvtpk(v0[0], v0[1]), cvtpk(v0[2], v0[3]), cvtpk(v1[0], v1[1]), cvtpk(v1[2], v1[3])};
                }
            }
    }
};

struct EpiOutProj {
    static constexpr bool PERM = false, AFTER_DRAIN = false;
    const float* X; float* Y; float* PART;
    DI void operator()(const f32x4 (&acc)[2][2][4][2], const pg8::Unit& u, int wr, int wc, int fr, int fq) const {
        const int rowb = u.pm * 256 + wr * 64 + fr, col0 = u.pn * 256 + wc * 32 + 4 * fq;
#pragma unroll
        for (int ai = 0; ai < 2; ++ai)
#pragma unroll
            for (int m = 0; m < 4; ++m) {
                const int row = rowb + ai * 128 + m * 16; float ss = 0.f;
#pragma unroll
                for (int bj = 0; bj < 2; ++bj)
#pragma unroll
                    for (int n = 0; n < 2; ++n) {
                        const size_t off = (size_t)row * DM + col0 + bj * 128 + n * 16;
                        const f32x4 h = *(const f32x4*)(X + off) + acc[ai][bj][m][n];
                        *(f32x4*)(Y + off) = h; ss += (h[0] * h[0] + h[1] * h[1]) + (h[2] * h[2] + h[3] * h[3]);
                    }
                ss += __shfl_xor(ss, 16); ss += __shfl_xor(ss, 32);
                if (fq == 0) PART[(size_t)row * 32 + u.pn * 4 + wc] = ss;
            }
    }
};

DI unsigned tile_off(unsigned row, unsigned ch) { return 256u * row + 16u * (ch ^ (((row & 3) << 2) | ((row >> 2) & 3))); }
DI unsigned vtile_off(unsigned row, unsigned ch) { return 256u * row + 16u * (ch ^ (((row & 3) << 2) | (((row >> 2) & 1) << 1))); }
typedef short v4i16_t __attribute__((ext_vector_type(4)));
DI s16x4 tr4(const LAS char* p) { return __builtin_bit_cast(s16x4, __builtin_amdgcn_ds_read_tr16_b64_v4i16((LAS v4i16_t*)p)); }
DI bf16x8 row_frag(const LAS char* img, int row0, int lane, int s) { return *(const LAS bf16x8*)(img + tile_off(row0 + (lane & 31), 2 * s + (lane >> 5))); }
DI bf16x8 tr_frag(const LAS char* img, int krow0, int col0, int lane) {
    const unsigned h = lane >> 5, blk = (lane >> 4) & 1, q = (lane & 15) >> 2, p = lane & 3, ch = (col0 >> 3) + 2 * blk + (p >> 1);
    const s16x4 lo = tr4(img + tile_off(krow0 + 8 * h + q, ch) + 8 * (p & 1)), hi = tr4(img + tile_off(krow0 + 8 * h + 4 + q, ch) + 8 * (p & 1));
    return __builtin_shufflevector(lo, hi, 0, 1, 2, 3, 4, 5, 6, 7);
}
DI bf16x8 tr_frag_perm(const LAS char* img, int krow0, int col0, int lane) {
    const unsigned h = lane >> 5, blk = (lane >> 4) & 1, q = (lane & 15) >> 2, p = lane & 3, ch = (col0 >> 3) + 2 * blk + (p >> 1);
    const s16x4 lo = tr4(img + tile_off(krow0 + 4 * h + q, ch) + 8 * (p & 1)), hi = tr4(img + tile_off(krow0 + 8 + 4 * h + q, ch) + 8 * (p & 1));
    return __builtin_shufflevector(lo, hi, 0, 1, 2, 3, 4, 5, 6, 7);
}
DI bf16x8 row_frag16(const LAS char* img, int row0, int lane, int s) { return *(const LAS bf16x8*)(img + tile_off(row0 + (lane & 15), 4 * s + (lane >> 4))); }
DI bf16x8 tr16_perm(const LAS char* img, int krow0, int c8, int lane) {
    const unsigned g = lane >> 4, q = (lane & 15) >> 2, p = lane & 3, ch = 2 * c8 + (p >> 1);
    const s16x4 lo = tr4(img + vtile_off(krow0 + 4 * g + q, ch) + 8 * (p & 1)), hi = tr4(img + vtile_off(krow0 + 16 + 4 * g + q, ch) + 8 * (p & 1));
    return __builtin_shufflevector(lo, hi, 0, 1, 2, 3, 4, 5, 6, 7);
}
template <int NROWS, bool VT> DI void load_tile(LAS char* img, const char* g, size_t gstride, int tid) {
#pragma unroll
    for (int i = 0; i < NROWS * 16 / 512; ++i) {
        const int n = tid + 512 * i, row = n >> 4, ch = n & 15;
        const u32x4 v = *(const u32x4*)(g + (size_t)row * gstride + ch * 16);
        *(LAS u32x4*)(img + (VT ? vtile_off(row, ch) : tile_off(row, ch))) = v;
    }
}
template <int NROWS> DI void tile_fetch(u32x4 (&v)[NROWS * 16 / 512], const char* g, size_t gstride, int tid) {
#pragma unroll
    for (int i = 0; i < NROWS * 16 / 512; ++i) { const int n = tid + 512 * i, row = n >> 4, ch = n & 15; v[i] = *(const u32x4*)(g + (size_t)row * gstride + ch * 16); }
}
template <int NROWS, bool VT> DI void tile_put(LAS char* img, const u32x4 (&v)[NROWS * 16 / 512], int tid) {
#pragma unroll
    for (int i = 0; i < NROWS * 16 / 512; ++i) { const int n = tid + 512 * i, row = n >> 4, ch = n & 15; *(LAS u32x4*)(img + (VT ? vtile_off(row, ch) : tile_off(row, ch))) = v[i]; }
}
DI f32x16 zero16() { f32x16 z;
#pragma unroll
    for (int i = 0; i < 16; ++i) z[i] = 0.f;
    return z; }
DI int crow(int r, int h) { return (r & 3) + 8 * (r >> 2) + 4 * h; }
#define MFMA32(a, b, c) __builtin_amdgcn_mfma_f32_32x32x16_bf16((a), (b), (c), 0, 0, 0)
#define MFMA16(a, b, c) __builtin_amdgcn_mfma_f32_16x16x32_bf16((a), (b), (c), 0, 0, 0)

constexpr int NWAVES = 8, NTHR = 512;
constexpr int RING_BYTES = 131072, MISC_OFF = RING_BYTES + 320, LDS_BYTES = 147456;
struct Frame {
    LAS unsigned char* lds; volatile LAS unsigned* MISC; unsigned* ctl;
    int tid, lane, wave, G, bid;
    const float *x, *xs, *cache_k, *cache_v, *cache_ki, *state, *norm_g, *w_in, *ret_g, *w_out, *fin_g; const int* ptab;
    float* out; unsigned char* ws;
};

#define XB_TMO      128
#define XB_XCNT(j)  (256  + 64 * (j))
#define XB_XSUB(j)  (1280 + 64 * (j))
#define XB_XGEN(j)  (2304 + 64 * (j))
#define XB_TOP      3328
#define XB_TOPGEN   3392
#define XCD_BAR_WORDS 3456
#define XB_SPIN_CAP (1u << 20)
constexpr int CW_BAR = 4096;
DI unsigned xb_ld(unsigned* p) { return __hip_atomic_load(p, __ATOMIC_RELAXED, __HIP_MEMORY_SCOPE_AGENT); }
DI unsigned xb_add(unsigned* p, unsigned v) { return __hip_atomic_fetch_add(p, v, __ATOMIC_RELAXED, __HIP_MEMORY_SCOPE_AGENT); }
DI unsigned xb_xcc_id() { return (unsigned)__builtin_amdgcn_s_getreg((3 << 11) | 20) & 0xFu; }
#define XB_SPIN(cond, bar) do { unsigned _sp = 0; while (cond) { __builtin_amdgcn_s_sleep(1); \
    if ((++_sp & 255u) == 0u) { if (xb_ld(&(bar)[XB_TMO])) break; if (_sp > XB_SPIN_CAP) { atomicAdd(&(bar)[XB_TMO], 1u); break; } } } } while (0)
struct XcdBarrier { unsigned* bar; unsigned x; volatile LAS unsigned* st; };
DI XcdBarrier xcd_barrier_post(unsigned* bar, volatile LAS unsigned* st) {
    XcdBarrier b; b.bar = bar; b.x = xb_xcc_id(); b.st = st;
    if (threadIdx.x == 0) (void)xb_add(&bar[XB_XCNT(b.x)], 1u);
    return b;
}
DI void xcd_barrier_complete(unsigned* bar, unsigned x, unsigned& nloc, unsigned& nx) {
    const unsigned G = gridDim.x * gridDim.y * gridDim.z;
    unsigned sum, cnt, mine, sp = 0u;
    for (;;) {
        sum = 0u; cnt = 0u; mine = 0u;
#pragma unroll
        for (unsigned j = 0; j < 16; ++j) { const unsigned c = xb_ld(&bar[XB_XCNT(j)]); sum += c; cnt += (c > 0u) ? 1u : 0u; mine = (j == x) ? c : mine; }
        if (sum == G) break;
        __builtin_amdgcn_s_sleep(1);
        if ((++sp & 255u) == 0u) { if (xb_ld(&bar[XB_TMO])) break; if (sp > XB_SPIN_CAP) { atomicAdd(&bar[XB_TMO], 1u); break; } }
    }
    nloc = mine > 0u ? mine : 1u; nx = cnt > 0u ? cnt : 1u;
}
DI void xcd_barrier(const XcdBarrier& b) {
    asm volatile("s_waitcnt vmcnt(0)" ::: "memory");
    __syncthreads();
    if (threadIdx.x == 0) {
        unsigned* bar = b.bar;
        __builtin_amdgcn_s_waitcnt(0);
        unsigned nloc = b.st[0], nx = b.st[1];
        if (nloc == 0u) { xcd_barrier_complete(bar, b.x, nloc, nx); b.st[0] = nloc; b.st[1] = nx; }
        const unsigned old = xb_add(&bar[XB_XSUB(b.x)], 1u);
        const unsigned gen = old / nloc;
        if (old + 1u == (gen + 1u) * nloc) {
            __builtin_amdgcn_fence(__ATOMIC_RELEASE, "agent");
            asm volatile("s_waitcnt vmcnt(0)" ::: "memory");
            const unsigned og = xb_add(&bar[XB_TOP], 1u);
            const unsigned tg = og / nx;
            if (og + 1u == (tg + 1u) * nx) xb_add(&bar[XB_TOPGEN], 1u);
            else XB_SPIN(xb_ld(&bar[XB_TOPGEN]) == tg, bar);
            __builtin_amdgcn_fence(__ATOMIC_ACQUIRE, "agent");
            xb_add(&bar[XB_XGEN(b.x)], 1u);
            asm volatile("s_waitcnt vmcnt(0)" ::: "memory");
        } else {
            XB_SPIN(xb_ld(&bar[XB_XGEN(b.x)]) == gen, bar);
            __builtin_amdgcn_fence(__ATOMIC_ACQUIRE, "agent");
            asm volatile("s_waitcnt vmcnt(0)" ::: "memory");
        }
    }
    __syncthreads();
}

template <class CMap> DI void p0_transpose_item(const float* W, int K, int ldw, bf16_t* WT, LAS float* scr, int item, int nblk, int lane, CMap cm) {
    const int kb = item / nblk, nb = item % nblk, k0 = 64 * kb, n0 = 32 * nb;
    const int col = cm(n0 + (lane & 31));
#pragma unroll 8
    for (int i = 0; i < 32; ++i) { const int kk = 2 * i + (lane >> 5); scr[kk * 33 + (lane & 31)] = (col >= 0) ? W[(size_t)(k0 + kk) * ldw + col] : 0.f; }
    LDS_WAIT(); asm volatile("" ::: "memory");
    const int c = lane & 7;
#pragma unroll
    for (int j = 0; j < 4; ++j) { const int n = (lane >> 3) + 8 * j; const LAS float* s = scr + (8 * c) * 33 + n;
        u32x4 o; o.x = cvtpk(s[0 * 33], s[1 * 33]); o.y = cvtpk(s[2 * 33], s[3 * 33]); o.z = cvtpk(s[4 * 33], s[5 * 33]); o.w = cvtpk(s[6 * 33], s[7 * 33]);
        *(u32x4*)(WT + (size_t)(n0 + n) * K + k0 + 8 * c) = o; }
    LDS_WAIT(); asm volatile("" ::: "memory");
}
template <bool OUTF> DI void rms_row(const float* xrow, const float* g, void* orow, int lane) {
    const f32x4* xr = (const f32x4*)xrow + lane; f32x4 v[8]; float s = 0.f;
#pragma unroll
    for (int j = 0; j < 8; ++j) { v[j] = xr[64 * j]; s += (v[j][0] * v[j][0] + v[j][1] * v[j][1]) + (v[j][2] * v[j][2] + v[j][3] * v[j][3]); }
    const float rstd = 1.0f / sqrtf(wave_sum(s) * (1.f / DM) + EPS);
#pragma unroll
    for (int j = 0; j < 8; ++j) { const f32x4 gv = ((const f32x4*)g)[lane + 64 * j]; const f32x4 o = v[j] * rstd * gv;
        if (OUTF) ((f32x4*)orow)[lane + 64 * j] = o;
        else ((u32x2*)orow)[lane + 64 * j] = (u32x2){cvtpk(o[0], o[1]), cvtpk(o[2], o[3])}; }
}
DI void rope_entry(float* CS, int idx) {
    const int p = idx >> 6, i = idx & 63; const float pos = (p == SEQ) ? (float)PAST : (float)p;
    const float ang = pos * ROPE_INV[i];
    const double a = (double)ang, q = __builtin_rint(a * 0.63661977236758134308);
    double r = __builtin_fma(-q, 1.57079632679489655800, a); r = __builtin_fma(-q, 6.12323399573676603587e-17, r);
    const double r2 = r * r;
    const double sp = r + r * r2 * (-1.0 / 6 + r2 * (1.0 / 120 + r2 * (-1.0 / 5040 + r2 * (1.0 / 362880 + r2 * (-1.0 / 39916800 + r2 * (1.0 / 6227020800.0))))));
    const double cp = 1.0 + r2 * (-0.5 + r2 * (1.0 / 24 + r2 * (-1.0 / 720 + r2 * (1.0 / 40320 + r2 * (-1.0 / 3628800 + r2 * (1.0 / 479001600.0 + r2 * (-1.0 / 87178291200.0)))))));
    const int n = (int)q & 3;
    const double c = (n == 0) ? cp : (n == 1) ? -sp : (n == 2) ? -cp : sp;
    const double s = (n == 0) ? sp : (n == 1) ? cp : (n == 2) ? -sp : -cp;
    CS[(size_t)p * 128 + i] = (float)c; CS[(size_t)p * 128 + 64 + i] = (float)s;
}
DI void p0_prologue(Frame& F) {
    LAS float* scr = (LAS float*)(F.lds + F.wave * 16384);
    const int gw = F.bid * NWAVES + F.wave, NGW = F.G * NWAVES;
    bf16_t* WT = (bf16_t*)(F.ws + WS_WT); bf16_t* WOT = (bf16_t*)(F.ws + WS_WOT); bf16_t* XN = (bf16_t*)(F.ws + WS_XN);
    constexpr int I_IN = (DM / 64) * (DINP / 32), I_OUT = (DM / 64) * (DM / 32);
    for (int it = gw; it < I_IN + I_OUT; it += NGW) {
        if (it < I_IN) p0_transpose_item(F.w_in, DM, DIN, WT, scr, it, DINP / 32, F.lane, [](int n) { return cmap_in(n); });
        else p0_transpose_item(F.w_out, DM, DM, WOT, scr, it - I_IN, DM / 32, F.lane, [](int n) { return n; });
    }
    for (int m = gw; m < MP; m += NGW) rms_row<false>(F.x + (size_t)m * DM, F.norm_g, XN + (size_t)m * DM, F.lane);
    if (F.bid == F.G - 1) rms_row<true>(F.xs + (size_t)F.wave * DM, F.norm_g, (float*)(F.ws + WS_XNS) + (size_t)F.wave * DM, F.lane);
    { const int gt = F.bid * NTHR + F.tid; float* CS = (float*)(F.ws + WS_CS);
      for (int idx = gt; idx < (SEQ + 1) * 64; idx += F.G * NTHR) rope_entry(CS, idx); }
}

DI void p1_sample_gemv(Frame& F) {
    LAS float* xs = (LAS float*)F.lds;
    const float* XNS = (const float*)(F.ws + WS_XNS);
    for (int i = F.tid; i < DB * DM / 4; i += NTHR) ((LAS f32x4*)xs)[i] = ((const f32x4*)XNS)[i];
    __syncthreads();
    const bf16_t* WT = (const bf16_t*)(F.ws + WS_WT); float* ZS = (float*)(F.ws + WS_ZS);
    const int gw = F.bid * NWAVES + F.wave, NGW = F.G * NWAVES, lane = F.lane;
    for (int n = gw; n < DIN; n += NGW) {
        asm volatile("" ::: "memory");
        const u32x4* wrow = (const u32x4*)(WT + (size_t)n * DM);
        float acc[8];
#pragma unroll
        for (int j = 0; j < 8; ++j) acc[j] = 0.f;
#pragma unroll
        for (int i = 0; i < 4; ++i) {
            const u32x4 w = wrow[lane + 64 * i];
            const float w0 = bflo(w.x), w1 = bfhi(w.x), w2 = bflo(w.y), w3 = bfhi(w.y), w4 = bflo(w.z), w5 = bfhi(w.z), w6 = bflo(w.w), w7 = bfhi(w.w);
#pragma unroll
            for (int j = 0; j < 8; ++j) {
                const LAS f32x4* xp = (const LAS f32x4*)(xs + j * DM + 8 * (lane + 64 * i));
                const f32x4 a = xp[0], b = xp[1];
                acc[j] += (a[0] * w0 + a[1] * w1) + (a[2] * w2 + a[3] * w3) + (b[0] * w4 + b[1] * w5) + (b[2] * w6 + b[3] * w7);
            }
        }
#pragma unroll
        for (int j = 0; j < 8; ++j) acc[j] = wave_sum(acc[j]);
        float r = acc[0];
#pragma unroll
        for (int j = 1; j < 8; ++j) r = (lane == j) ? acc[j] : r;
        if (lane < 8) ZS[(size_t)lane * DIN + cmap_in(n)] = r;
    }
    __syncthreads();
}

DI void p2_indexer_unit(Frame& F, int b, int j8) {
    LAS char* L = (LAS char*)F.lds;
    LAS char* KB0 = L;
    LAS char* KB1 = L + 32768;
    LAS float* SC = (LAS float*)(L + 65536);
    const int tid = F.tid, lane = F.lane, w = F.wave, wm = w & 3, wn = w >> 2, hh = lane >> 5;
    const int t0 = 8 * j8, R0 = b * SEQ + t0, NT = ((t0 + 7) >> 7) + 1;
    const bf16_t* QI = (const bf16_t*)(F.ws + WS_QI); const bf16_t* KI = (const bf16_t*)(F.ws + WS_KI); const float* WI = (const float*)(F.ws + WS_WI);
    load_tile<128, false>(KB1, (const char*)(QI + (size_t)R0 * 2048), 256, tid);
    load_tile<128, false>(KB0, (const char*)(KI + (size_t)b * SEQ * 128), 256, tid);
    __syncthreads();
    bf16x8 qf[8];
#pragma unroll
    for (int s = 0; s < 8; ++s) qf[s] = row_frag(KB1, 32 * wm, lane, s);
    float wv[16];
#pragma unroll
    for (int r = 0; r < 16; ++r) wv[r] = WI[(size_t)(R0 + 2 * wm + (r >> 3)) * 16 + (r & 3) + 8 * ((r >> 2) & 1) + 4 * hh];
    __syncthreads();
    u32x4 kreg[4];
    for (int T = 0; T < NT; ++T) {
        LAS char* KB = (T & 1) ? KB1 : KB0;
        if (T + 1 < NT) tile_fetch<128>(kreg, (const char*)(KI + ((size_t)b * SEQ + 128 * (T + 1)) * 128), 256, tid);
#pragma unroll
        for (int nb = 0; nb < 2; ++nb) {
            f32x16 acc = zero16();
#pragma unroll
            for (int s = 0; s < 8; ++s) acc = MFMA32(qf[s], row_frag(KB, 64 * wn + 32 * nb, lane, s), acc);
            float p0 = 0.f, p1 = 0.f;
#pragma unroll
            for (int r = 0; r < 8; ++r) { p0 += wv[r] * fmaxf(acc[r], 0.f); p1 += wv[8 + r] * fmaxf(acc[8 + r], 0.f); }
            p0 += __shfl_xor(p0, 32); p1 += __shfl_xor(p1, 32);
            const int key = 128 * T + 64 * wn + 32 * nb + (lane & 31);
            SC[(2 * wm + hh) * 2048 + key] = hh ? p1 : p0;
        }
        if (T + 1 < NT) tile_put<128, false>((T & 1) ? KB0 : KB1, kreg, tid);
        __syncthreads();
    }
    const int t = t0 + w; unsigned u[32];
#pragma unroll
    for (int i = 0; i < 32; ++i) { const int k = 64 * i + lane; u[i] = (k <= t) ? fkey(SC[w * 2048 + k]) : 0u; }
    unsigned long long* MASK = (unsigned long long*)(F.ws + WS_MASK) + (size_t)(R0 + w) * 32;
    unsigned thr = 1u; int need_eq = 0; unsigned idx_cut = 0xffffffffu;
    bool all = (t + 1 <= TOPK);
    unsigned T_sel = 0u;
    bool tie = false;
    if (!all) {
        unsigned prefix = 0u; bool exact = false;
        for (int bit = 31; bit >= 0; --bit) {
            const unsigned cand = prefix | (1u << bit); int cnt = 0;
#pragma unroll
            for (int i = 0; i < 32; ++i) cnt += __popcll(__ballot(u[i] >= cand));
            if (cnt >= TOPK) prefix = cand;
            if (cnt == TOPK) { exact = true; break; }
        }
        T_sel = prefix;
        if (!exact) {
            int cgt = 0;
#pragma unroll
            for (int i = 0; i < 32; ++i) cgt += __popcll(__ballot(u[i] > prefix));
            need_eq = TOPK - cgt; tie = true;
            unsigned lo = 0u, hi = 2047u;
            while (lo < hi) { const unsigned mid = (lo + hi) >> 1; int c = 0;
#pragma unroll
                for (int i = 0; i < 32; ++i) c += __popcll(__ballot(u[i] == prefix && (unsigned)(64 * i + lane) <= mid));
                if (c >= need_eq) hi = mid; else lo = mid + 1u; }
            idx_cut = lo;
        }
    }
    (void)thr;
#pragma unroll
    for (int i = 0; i < 32; ++i) {
        const unsigned k = 64 * i + lane; bool sel;
        if (all) sel = (int)k <= t;
        else if (!tie) sel = u[i] >= T_sel;
        else sel = (u[i] > T_sel) || (u[i] == T_sel && k <= idx_cut);
        const unsigned long long m = __ballot(sel);
        if (lane == 0) MASK[i] = m;
    }
    __syncthreads();
}

DI void p2_retA_unit(Frame& F, int bh, int c) {
    LAS char* L = (LAS char*)F.lds; LAS char* KIMG = L; LAS char* VIMG = L + 32768;
    const int b = bh >> 3, h = bh & 7, R0 = b * SEQ + c * CH, lane = F.lane, w = F.wave, dt = w >> 1, eh = w & 1, hh = lane >> 5;
    const bf16_t* KR = (const bf16_t*)(F.ws + WS_KR); const bf16_t* VR = (const bf16_t*)(F.ws + WS_VR);
    load_tile<128, false>(KIMG, (const char*)(KR + (size_t)R0 * 1024 + h * 128), 2048, F.tid);
    load_tile<128, false>(VIMG, (const char*)(VR + (size_t)R0 * 1024 + h * 128), 2048, F.tid);
    __syncthreads();
    f32x16 acc[2] = {zero16(), zero16()};
#pragma unroll
    for (int ks = 0; ks < 8; ++ks) {
        const bf16x8 a = tr_frag(KIMG, 16 * ks, 32 * dt, lane);
#pragma unroll
        for (int e2 = 0; e2 < 2; ++e2) acc[e2] = MFMA32(a, tr_frag(VIMG, 16 * ks, 32 * (2 * eh + e2), lane), acc[e2]);
    }
    float* KV = (float*)(F.ws + WS_KV) + ((size_t)bh * NCH + c) * 16384;
#pragma unroll
    for (int e2 = 0; e2 < 2; ++e2)
#pragma unroll
        for (int r = 0; r < 16; ++r) KV[(32 * dt + crow(r, hh)) * 128 + 32 * (2 * eh + e2) + (lane & 31)] = acc[e2][r];
    __syncthreads();
}

DI void p2_sample_scores(Frame& F) {
    const int g = F.bid, b = g >> 5, lane = F.lane, key16 = lane & 15, gq = lane >> 4;
    const float* ZS = (const float*)(F.ws + WS_ZS) + (size_t)b * DIN;
    f32x4 qa[8];
#pragma unroll
    for (int t = 0; t < 8; ++t) qa[t] = *(const f32x4*)(ZS + C_QI + key16 * 128 + 16 * t + 4 * gq);
    float wv[4];
#pragma unroll
    for (int r = 0; r < 4; ++r) wv[r] = ZS[C_WI + 4 * gq + r] * WI_SCALE;
    float* SCS = (float*)(F.ws + WS_SCS) + (size_t)b * PAST;
    for (int grp = 0; grp < 4; ++grp) {
        const int s0 = 512 * (g & 31) + 64 * F.wave + 16 * grp, s = s0 + key16;
        const int page = F.ptab[b * NPAGES + (s >> 7)];
        const float* krow = F.cache_ki + ((size_t)page * PAGE + (s & 127)) * DIDX;
        f32x4 kb[8];
#pragma unroll
        for (int t = 0; t < 8; ++t) kb[t] = *(const f32x4*)(krow + 16 * t + 4 * gq);
        f32x4 acc = {0.f, 0.f, 0.f, 0.f};
#pragma unroll
        for (int t = 0; t < 8; ++t)
#pragma unroll
            for (int i = 0; i < 4; ++i) acc = __builtin_amdgcn_mfma_f32_16x16x4f32(qa[t][i], kb[t][i], acc, 0, 0, 0);
        float p = 0.f;
#pragma unroll
        for (int r = 0; r < 4; ++r) p += wv[r] * fmaxf(acc[r], 0.f);
        p += __shfl_xor(p, 16); p += __shfl_xor(p, 32);
        if (gq == 0) SCS[s] = p;
    }
}

DI void p2_sample_retention(Frame& F, int b, int h) {
    LAS float* LQ = (LAS float*)F.lds;
    LAS float* LK = LQ + 128; LAS float* LP = LQ + 256; LAS float* LO = LQ + 768;
    const float* ZS = (const float*)(F.ws + WS_ZS) + (size_t)b * DIN; const float* CS = (const float*)(F.ws + WS_CS) + (size_t)SEQ * 128;
    const int tid = F.tid;
    if (tid < 64) {
        const float c = CS[tid], s = CS[64 + tid];
        const float q1 = ZS[C_QR + h * 128 + tid], q2 = ZS[C_QR + h * 128 + 64 + tid], k1 = ZS[C_KR + h * 128 + tid], k2 = ZS[C_KR + h * 128 + 64 + tid];
        LQ[tid] = q1 * c - q2 * s; LQ[64 + tid] = q1 * s + q2 * c;
        LK[tid] = (k1 * c - k2 * s) * KSCALE; LK[64 + tid] = (k1 * s + k2 * c) * KSCALE;
    }
    __syncthreads();
    const int e = tid & 127, dq = tid >> 7; const float gam = 1.0f - __builtin_amdgcn_exp2f((float)(-5 - h));
    const float v = ZS[C_VR + h * 128 + e];
    const float* S = F.state + ((size_t)(b * NRH + h)) * 16384; float* SN = F.out + O_STS + ((size_t)(b * NRH + h)) * 16384;
    float part = 0.f;
#pragma unroll 8
    for (int dd = 0; dd < 32; ++dd) { const int d = 32 * dq + dd; const float sv = S[d * 128 + e]; part += LQ[d] * sv; SN[d * 128 + e] = gam * sv + LK[d] * v; }
    LP[dq * 128 + e] = part;
    __syncthreads();
    if (tid < 128) {
        float qk = 0.f;
#pragma unroll 8
        for (int d = 0; d < 128; ++d) qk += LQ[d] * LK[d];
        LO[tid] = qk * v + gam * ((LP[tid] + LP[128 + tid]) + (LP[256 + tid] + LP[384 + tid]));
    }
    __syncthreads();
    if (F.wave == 0) {
        const float o0 = LO[F.lane], o1 = LO[64 + F.lane];
        const float mu = wave_sum(o0 + o1) * (1.f / 128); const float d0 = o0 - mu, d1 = o1 - mu;
        const float rs = 1.0f / sqrtf(wave_sum(d0 * d0 + d1 * d1) * (1.f / 128) + EPS);
        float* ACTS = (float*)(F.ws + WS_ACTS) + (size_t)b * DM + h * 128;
        ACTS[F.lane] = d0 * rs * F.ret_g[h * 128 + F.lane] * silu(ZS[C_GR + h * 128 + F.lane]);
        ACTS[64 + F.lane] = d1 * rs * F.ret_g[h * 128 + 64 + F.lane] * silu(ZS[C_GR + h * 128 + 64 + F.lane]);
    }
    __syncthreads();
}

DI void p3_scan(Frame& F) {
    const int gt = F.bid * NTHR + F.tid;
    if (gt >= 32 * 4096) return;
    const int bh = gt >> 12, e4 = (gt & 4095) * 4, h = bh & 7;
    const float g128 = __builtin_amdgcn_exp2f(128.f * l2g(h));
    const float* KV = (const float*)(F.ws + WS_KV) + (size_t)bh * NCH * 16384 + e4; bf16_t* SP = (bf16_t*)(F.ws + WS_SP) + (size_t)bh * NCH * 16384 + e4;
    f32x4 S = {0.f, 0.f, 0.f, 0.f};
#pragma unroll 4
    for (int c = 0; c < NCH; ++c) {
        S = (S + *(const f32x4*)(KV + (size_t)c * 16384)) * g128;
        if (c + 1 < NCH) *(u32x2*)(SP + (size_t)(c + 1) * 16384) = (u32x2){cvtpk(S[0], S[1]), cvtpk(S[2], S[3])};
    }
    *(f32x4*)(F.out + O_ST + (size_t)bh * 16384 + e4) = S;
}

DI int wg_count(LAS unsigned* LU, int w, int lane, int c) {
    if (lane == 0) LU[w] = (unsigned)c;
    __syncthreads();
    int tot = 0;
#pragma unroll
    for (int i = 0; i < 8; ++i) tot += (int)LU[i];
    __syncthreads();
    return tot;
}
DI void p3_sample_attend(Frame& F, int b) {
    LAS unsigned* LU = (LAS unsigned*)F.lds;
    LAS int* LIST = (LAS int*)(F.lds + 256);
    LAS int* LROW = (LAS int*)(F.lds + 1280);
    LAS float* LG = (LAS float*)(F.lds + 4096);
    LAS float* LQA = (LAS float*)(F.lds + 12288);
    LAS float* LRED = (LAS float*)(F.lds + 16384);
    const int tid = F.tid, lane = F.lane, w = F.wave;
    const float* ZS = (const float*)(F.ws + WS_ZS) + (size_t)b * DIN; const float* SCS = (const float*)(F.ws + WS_SCS) + (size_t)b * PAST;
    for (int i = tid; i < 1024; i += NTHR) LQA[i] = ZS[C_QA + i];
    if (w == 0) {
        const int hh = lane >> 2, qd = lane & 3; float p = 0.f;
#pragma unroll 8
        for (int d = 0; d < 32; ++d) p += ZS[C_QI + hh * 128 + 32 * qd + d] * ZS[C_KI + 32 * qd + d];
        p += __shfl_xor(p, 1); p += __shfl_xor(p, 2);
        float sc = ZS[C_WI + hh] * WI_SCALE * fmaxf(p, 0.f);
        sc += __shfl_xor(sc, 4); sc += __shfl_xor(sc, 8); sc += __shfl_xor(sc, 16); sc += __shfl_xor(sc, 32);
        if (lane == 0) LU[16] = fkey(sc);
    }
    __syncthreads();
    unsigned u[33];
#pragma unroll
    for (int i = 0; i < 32; ++i) u[i] = fkey(SCS[tid + 512 * i]);
    u[32] = (tid == 0) ? LU[16] : 0u;
    unsigned prefix = 0u; bool exact = false;
    for (int bit = 31; bit >= 0; --bit) {
        const unsigned cand = prefix | (1u << bit); int c = 0;
#pragma unroll
        for (int i = 0; i < 33; ++i) c += __popcll(__ballot(u[i] >= cand));
        const int tot = wg_count(LU, w, lane, c);
        if (tot >= TOPK) prefix = cand;
        if (tot == TOPK) { exact = true; break; }
    }
    unsigned idx_cut = 0xffffffffu;
    if (!exact) {
        int c = 0;
#pragma unroll
        for (int i = 0; i < 33; ++i) c += __popcll(__ballot(u[i] > prefix));
        const int need = TOPK - wg_count(LU, w, lane, c); unsigned lo = 0u, hi = (unsigned)PAST;
        while (lo < hi) {
            const unsigned mid = (lo + hi) >> 1; int cc = 0;
#pragma unroll
            for (int i = 0; i < 33; ++i) cc += __popcll(__ballot(u[i] == prefix && (unsigned)(tid + 512 * i) <= mid));
            if (wg_count(LU, w, lane, cc) >= need) hi = mid; else lo = mid + 1u;
        }
        idx_cut = lo;
    }
    int mycnt = 0;
#pragma unroll
    for (int i = 0; i < 33; ++i) { const bool sel = exact ? (u[i] >= prefix && u[i] != 0u) : ((u[i] > prefix) || (u[i] == prefix && (unsigned)(tid + 512 * i) <= idx_cut)); mycnt += __popcll(__ballot(sel)); }
    if (lane == 0) LU[w] = (unsigned)mycnt;
    __syncthreads();
    int base = 0;
#pragma unroll
    for (int i = 0; i < 8; ++i) base += (i < w) ? (int)LU[i] : 0;
#pragma unroll
    for (int i = 0; i < 33; ++i) {
        const bool sel = exact ? (u[i] >= prefix && u[i] != 0u) : ((u[i] > prefix) || (u[i] == prefix && (unsigned)(tid + 512 * i) <= idx_cut));
        const unsigned long long m = __ballot(sel);
        if (sel) { const int pos = base + __popcll(m & ((1ull << lane) - 1ull)); if (pos < TOPK) LIST[pos] = tid + 512 * i; }
        base += __popcll(m);
    }
    __syncthreads();
    if (tid < TOPK) { const int idx = LIST[tid]; int rb = -1; if (idx < PAST) { const int page = F.ptab[b * NPAGES + (idx >> 7)]; rb = (page * PAGE + (idx & 127)) * (NKV * HD); } LROW[tid] = rb; }
    __syncthreads();
    {
        const int kk = tid >> 1, c = tid & 1, rb = LROW[kk];
        const float* krow = (rb >= 0) ? (F.cache_k + (size_t)rb + c * HD) : (ZS + C_KA + c * HD);
        float a0 = 0.f, a1 = 0.f, a2 = 0.f, a3 = 0.f;
        const LAS float* q = LQA + (4 * c) * 128;
#pragma unroll 16
        for (int d4 = 0; d4 < 32; ++d4) {
            const f32x4 kv = *(const f32x4*)(krow + 4 * d4);
            const f32x4 q0 = *(const LAS f32x4*)(q + 4 * d4), q1 = *(const LAS f32x4*)(q + 128 + 4 * d4), q2 = *(const LAS f32x4*)(q + 256 + 4 * d4), q3 = *(const LAS f32x4*)(q + 384 + 4 * d4);
            a0 += (kv[0] * q0[0] + kv[1] * q0[1]) + (kv[2] * q0[2] + kv[3] * q0[3]);
            a1 += (kv[0] * q1[0] + kv[1] * q1[1]) + (kv[2] * q1[2] + kv[3] * q1[3]);
            a2 += (kv[0] * q2[0] + kv[1] * q2[1]) + (kv[2] * q2[2] + kv[3] * q2[3]);
            a3 += (kv[0] * q3[0] + kv[1] * q3[1]) + (kv[2] * q3[2] + kv[3] * q3[3]);
        }
        LG[(4 * c + 0) * 256 + kk] = a0 * KSCALE; LG[(4 * c + 1) * 256 + kk] = a1 * KSCALE; LG[(4 * c + 2) * 256 + kk] = a2 * KSCALE; LG[(4 * c + 3) * 256 + kk] = a3 * KSCALE;
    }
    __syncthreads();
    {
        float l[4]; float mx = -3.0e38f;
#pragma unroll
        for (int i = 0; i < 4; ++i) { l[i] = LG[w * 256 + lane + 64 * i]; mx = fmaxf(mx, l[i]); }
#pragma unroll
        for (int o = 1; o < 64; o <<= 1) mx = fmaxf(mx, __shfl_xor(mx, o));
        float sum = 0.f;
#pragma unroll
        for (int i = 0; i < 4; ++i) { l[i] = __expf(l[i] - mx); sum += l[i]; }
        sum = wave_sum(sum); const float inv = 1.0f / sum;
#pragma unroll
        for (int i = 0; i < 4; ++i) LG[w * 256 + lane + 64 * i] = l[i] * inv;
    }
    __syncthreads();
    {
        const int c = tid >> 8, kg = (tid >> 5) & 7, d4 = tid & 31;
        f32x4 o[4];
#pragma unroll
        for (int h4 = 0; h4 < 4; ++h4) o[h4] = (f32x4){0.f, 0.f, 0.f, 0.f};
#pragma unroll 8
        for (int i = 0; i < 32; ++i) {
            const int kk = kg + 8 * i, rb = LROW[kk];
            const float* vrow = (rb >= 0) ? (F.cache_v + (size_t)rb + c * HD) : (ZS + C_VA + c * HD);
            const f32x4 vv = *(const f32x4*)(vrow + 4 * d4);
#pragma unroll
            for (int h4 = 0; h4 < 4; ++h4) o[h4] = o[h4] + vv * LG[(4 * c + h4) * 256 + kk];
        }
#pragma unroll
        for (int h4 = 0; h4 < 4; ++h4) *(LAS f32x4*)(LRED + (kg * 8 + 4 * c + h4) * 128 + 4 * d4) = o[h4];
    }
    __syncthreads();
    {
        float* ACTS = (float*)(F.ws + WS_ACTS) + (size_t)b * DM + 1024;
#pragma unroll
        for (int r = 0; r < 2; ++r) {
            const int e = tid + 512 * r; float s = 0.f;
#pragma unroll
            for (int kg = 0; kg < 8; ++kg) s += LRED[kg * 1024 + e];
            ACTS[e] = s * silu(ZS[C_GA + e]);
        }
    }
    __syncthreads();
}

DI void p4_attn_unit(Frame& F, int b, int j16) {
    LAS char* L = (LAS char*)F.lds;
    const int tid = F.tid, lane = F.lane, w = F.wave, c = w >> 2, q16 = lane & 15, g = lane >> 4;
    const int t0 = 16 * j16, R0 = b * SEQ + t0, NT = (t0 >> 6) + 1;
    const bf16_t* QA = (const bf16_t*)(F.ws + WS_QA); const bf16_t* KA = (const bf16_t*)(F.ws + WS_KA); const bf16_t* VA = (const bf16_t*)(F.ws + WS_VA);
    const unsigned long long* MASK = (const unsigned long long*)(F.ws + WS_MASK) + (size_t)(R0 + q16) * 32;
    bf16x8 qf[4];
#pragma unroll
    for (int s = 0; s < 4; ++s) qf[s] = *(const bf16x8*)(QA + (size_t)(R0 + q16) * 1024 + w * 128 + 32 * s + 8 * g);
    f32x4 ot[8];
#pragma unroll
    for (int i = 0; i < 8; ++i) ot[i] = (f32x4){0.f, 0.f, 0.f, 0.f};
    float mrun = -1.0e30f, lrun = 0.f;
    u32x4 kr[4], vr[4];
#define ATT_FETCH(T_) do { const char* kg = (const char*)(KA + ((size_t)b * SEQ + 64 * (T_)) * 256); const char* vg = (const char*)(VA + ((size_t)b * SEQ + 64 * (T_)) * 256); \
        _Pragma("unroll") for (int i = 0; i < 4; ++i) { const int n = tid + 512 * i, row = n >> 5, cc = (n >> 4) & 1, ch = n & 15; \
            kr[i] = *(const u32x4*)(kg + (size_t)row * 512 + cc * 256 + ch * 16); vr[i] = *(const u32x4*)(vg + (size_t)row * 512 + cc * 256 + ch * 16); } } while (0)
#define ATT_PUT(buf_) do { _Pragma("unroll") for (int i = 0; i < 4; ++i) { const int n = tid + 512 * i, row = n >> 5, cc = (n >> 4) & 1, ch = n & 15; \
            *(LAS u32x4*)(L + (buf_) * 65536 + cc * 16384 + tile_off(row, ch)) = kr[i]; *(LAS u32x4*)(L + (buf_) * 65536 + 32768 + cc * 16384 + vtile_off(row, ch)) = vr[i]; } } while (0)
    ATT_FETCH(0); ATT_PUT(0);
    __syncthreads();
    for (int T = 0; T < NT; ++T) {
        LAS char* KIMG = L + (T & 1) * 65536; LAS char* VIMG = KIMG + 32768;
        if (T + 1 < NT) ATT_FETCH(T + 1);
        const unsigned long long mw = MASK[T] >> (4 * g);
        const unsigned mlo = (unsigned)mw, mhi = (unsigned)(mw >> 32);
        f32x4 st[4];
#pragma unroll
        for (int kb = 0; kb < 4; ++kb) {
            st[kb] = (f32x4){0.f, 0.f, 0.f, 0.f};
#pragma unroll
            for (int s = 0; s < 4; ++s) st[kb] = MFMA16(row_frag16(KIMG + c * 16384, 16 * kb, lane, s), qf[s], st[kb]);
        }
        float mt = -1.0e30f;
#pragma unroll
        for (int kb = 0; kb < 4; ++kb)
#pragma unroll
            for (int r = 0; r < 4; ++r) { const unsigned bit = ((kb < 2 ? mlo : mhi) >> (16 * (kb & 1) + r)) & 1u; st[kb][r] = bit ? st[kb][r] : -1.0e30f; mt = fmaxf(mt, st[kb][r]); }
        mt = fmaxf(mt, __shfl_xor(mt, 16)); mt = fmaxf(mt, __shfl_xor(mt, 32));
        const float mnew = fmaxf(mrun, mt), alpha = __builtin_amdgcn_exp2f(mrun - mnew);
        mrun = mnew; lrun *= alpha;
#pragma unroll
        for (int i = 0; i < 8; ++i) ot[i] = ot[i] * alpha;
        float ps = 0.f;
#pragma unroll
        for (int kb = 0; kb < 4; ++kb)
#pragma unroll
            for (int r = 0; r < 4; ++r) { const float p = (st[kb][r] > -0.5e30f) ? __builtin_amdgcn_exp2f(st[kb][r] - mnew) : 0.f; st[kb][r] = p; ps += p; }
        lrun += ps;
#pragma unroll
        for (int ks = 0; ks < 2; ++ks) {
            const u32x4 pw = {cvtpk(st[2 * ks][0], st[2 * ks][1]), cvtpk(st[2 * ks][2], st[2 * ks][3]), cvtpk(st[2 * ks + 1][0], st[2 * ks + 1][1]), cvtpk(st[2 * ks + 1][2], st[2 * ks + 1][3])};
            const bf16x8 pb = __builtin_bit_cast(bf16x8, pw);
#pragma unroll
            for (int c8 = 0; c8 < 8; ++c8) ot[c8] = MFMA16(tr16_perm(VIMG + c * 16384, 32 * ks, c8, lane), pb, ot[c8]);
        }
        if (T + 1 < NT) ATT_PUT((T + 1) & 1);
        __syncthreads();
    }
#undef ATT_FETCH
#undef ATT_PUT
    lrun += __shfl_xor(lrun, 16); lrun += __shfl_xor(lrun, 32);
    const float inv = 1.0f / lrun;
    const bf16_t* GA = (const bf16_t*)(F.ws + WS_GA) + (size_t)(R0 + q16) * 1024 + w * 128; bf16_t* ACT = (bf16_t*)(F.ws + WS_ACT) + (size_t)(R0 + q16) * DM + 1024 + w * 128;
#pragma unroll
    for (int c8 = 0; c8 < 8; ++c8) {
        const int d = 16 * c8 + 4 * g; const u32x2 gw = *(const u32x2*)(GA + d);
        const float o0 = ot[c8][0] * inv * bflo(gw.x), o1 = ot[c8][1] * inv * bfhi(gw.x), o2 = ot[c8][2] * inv * bflo(gw.y), o3 = ot[c8][3] * inv * bfhi(gw.y);
        *(u32x2*)(ACT + d) = (u32x2){cvtpk(o0, o1), cvtpk(o2, o3)};
    }
}

DI void p4_retB_unit(Frame& F, int bh, int c) {
    LAS char* L = (LAS char*)F.lds; LAS char* QIMG = L; LAS char* KIMG = L + 32768; LAS char* VIMG = L + 65536; LAS char* SIMG = L + 98304;
    LAS float* OUT = (LAS float*)L;
    const int b = bh >> 3, h = bh & 7, R0 = b * SEQ + c * CH, tid = F.tid, lane = F.lane, w = F.wave, it = w >> 1, eh = w & 1, hh = lane >> 5;
    const bf16_t* QR = (const bf16_t*)(F.ws + WS_QR); const bf16_t* KR = (const bf16_t*)(F.ws + WS_KR); const bf16_t* VR = (const bf16_t*)(F.ws + WS_VR);
    __syncthreads();
    load_tile<128, false>(QIMG, (const char*)(QR + (size_t)R0 * 1024 + h * 128), 2048, tid);
    load_tile<128, false>(KIMG, (const char*)(KR + (size_t)R0 * 1024 + h * 128), 2048, tid);
    load_tile<128, false>(VIMG, (const char*)(VR + (size_t)R0 * 1024 + h * 128), 2048, tid);
    if (c > 0) load_tile<128, false>(SIMG, (const char*)((const bf16_t*)(F.ws + WS_SP) + ((size_t)bh * NCH + c) * 16384), 256, tid);
    __syncthreads();
    f32x16 acc[2] = {zero16(), zero16()};
    bf16x8 qf[8];
#pragma unroll
    for (int s = 0; s < 8; ++s) qf[s] = row_frag(QIMG, 32 * it, lane, s);
    if (c > 0) {
#pragma unroll
        for (int s = 0; s < 8; ++s)
#pragma unroll
            for (int e2 = 0; e2 < 2; ++e2) acc[e2] = MFMA32(qf[s], tr_frag(SIMG, 16 * s, 32 * (2 * eh + e2), lane), acc[e2]);
    }
    for (int jt = 0; jt <= it; ++jt) {
        f32x16 X = zero16();
#pragma unroll
        for (int s = 0; s < 8; ++s) X = MFMA32(row_frag(KIMG, 32 * jt, lane, s), qf[s], X);
        if (jt == it) {
#pragma unroll
            for (int r = 0; r < 16; ++r) X[r] = (crow(r, hh) > (lane & 31)) ? 0.f : X[r];
        }
#pragma unroll
        for (int s2 = 0; s2 < 2; ++s2) {
            const u32x4 pw = {cvtpk(X[8 * s2 + 0], X[8 * s2 + 1]), cvtpk(X[8 * s2 + 2], X[8 * s2 + 3]), cvtpk(X[8 * s2 + 4], X[8 * s2 + 5]), cvtpk(X[8 * s2 + 6], X[8 * s2 + 7])};
            const bf16x8 xs = __builtin_bit_cast(bf16x8, pw);
#pragma unroll
            for (int e2 = 0; e2 < 2; ++e2) acc[e2] = MFMA32(xs, tr_frag_perm(VIMG, 32 * jt + 16 * s2, 32 * (2 * eh + e2), lane), acc[e2]);
        }
    }
    __syncthreads();
#pragma unroll
    for (int e2 = 0; e2 < 2; ++e2)
#pragma unroll
        for (int r = 0; r < 16; ++r) OUT[(32 * it + crow(r, hh)) * 129 + 32 * (2 * eh + e2) + (lane & 31)] = acc[e2][r];
    __syncthreads();
    {
        const int i = tid >> 2, qd = tid & 3; float v[32]; float s = 0.f;
#pragma unroll
        for (int e = 0; e < 32; ++e) { v[e] = OUT[i * 129 + 32 * qd + e]; s += v[e]; }
        s += __shfl_xor(s, 1); s += __shfl_xor(s, 2);
        const float mu = s * (1.f / 128); float q = 0.f;
#pragma unroll
        for (int e = 0; e < 32; ++e) { v[e] -= mu; q += v[e] * v[e]; }
        q += __shfl_xor(q, 1); q += __shfl_xor(q, 2);
        const float rs = 1.0f / sqrtf(q * (1.f / 128) + EPS);
        const bf16_t* GR = (const bf16_t*)(F.ws + WS_GR) + (size_t)(R0 + i) * 1024 + h * 128 + 32 * qd; bf16_t* ACT = (bf16_t*)(F.ws + WS_ACT) + (size_t)(R0 + i) * DM + h * 128 + 32 * qd;
        const float* rg = F.ret_g + h * 128 + 32 * qd;
#pragma unroll
        for (int e8 = 0; e8 < 4; ++e8) {
            const u32x4 gw = *(const u32x4*)(GR + 8 * e8); const f32x4 g0 = *(const f32x4*)(rg + 8 * e8), g1 = *(const f32x4*)(rg + 8 * e8 + 4);
            const float o0 = v[8 * e8 + 0] * rs * g0[0] * bflo(gw.x), o1 = v[8 * e8 + 1] * rs * g0[1] * bfhi(gw.x), o2 = v[8 * e8 + 2] * rs * g0[2] * bflo(gw.y), o3 = v[8 * e8 + 3] * rs * g0[3] * bfhi(gw.y);
            const float o4 = v[8 * e8 + 4] * rs * g1[0] * bflo(gw.z), o5 = v[8 * e8 + 5] * rs * g1[1] * bfhi(gw.z), o6 = v[8 * e8 + 6] * rs * g1[2] * bflo(gw.w), o7 = v[8 * e8 + 7] * rs * g1[3] * bfhi(gw.w);
            *(u32x4*)(ACT + 8 * e8) = (u32x4){cvtpk(o0, o1), cvtpk(o2, o3), cvtpk(o4, o5), cvtpk(o6, o7)};
        }
    }
    __syncthreads();
}

DI void p5_sample_outproj(Frame& F) {
    LAS float* xs = (LAS float*)F.lds;
    const float* ACTS = (const float*)(F.ws + WS_ACTS);
    for (int i = F.tid; i < DB * DM / 4; i += NTHR) ((LAS f32x4*)xs)[i] = ((const f32x4*)ACTS)[i];
    __syncthreads();
    const bf16_t* WOT = (const bf16_t*)(F.ws + WS_WOT);
    const int gw = F.bid * NWAVES + F.wave, NGW = F.G * NWAVES, lane = F.lane;
    for (int n = gw; n < DM; n += NGW) {
        asm volatile("" ::: "memory");
        const u32x4* wrow = (const u32x4*)(WOT + (size_t)n * DM);
        float acc[8];
#pragma unroll
        for (int j = 0; j < 8; ++j) acc[j] = 0.f;
#pragma unroll
        for (int i = 0; i < 4; ++i) {
            const u32x4 w = wrow[lane + 64 * i];
            const float w0 = bflo(w.x), w1 = bfhi(w.x), w2 = bflo(w.y), w3 = bfhi(w.y), w4 = bflo(w.z), w5 = bfhi(w.z), w6 = bflo(w.w), w7 = bfhi(w.w);
#pragma unroll
            for (int j = 0; j < 8; ++j) {
                const LAS f32x4* xp = (const LAS f32x4*)(xs + j * DM + 8 * (lane + 64 * i));
                const f32x4 a = xp[0], b = xp[1];
                acc[j] += (a[0] * w0 + a[1] * w1) + (a[2] * w2 + a[3] * w3) + (b[0] * w4 + b[1] * w5) + (b[2] * w6 + b[3] * w7);
            }
        }
#pragma unroll
        for (int j = 0; j < 8; ++j) acc[j] = wave_sum(acc[j]);
        float r = acc[0];
#pragma unroll
        for (int j = 1; j < 8; ++j) r = (lane == j) ? acc[j] : r;
        if (lane < 8) F.out[O_YS + (size_t)lane * DM + n] = F.xs[(size_t)lane * DM + n] + r;
    }
    __syncthreads();
}

DI void p6_final_norm(Frame& F) {
    const int gw = F.bid * NWAVES + F.wave, NGW = F.G * NWAVES, lane = F.lane;
    const float* PART = (const float*)(F.ws + WS_PART);
    for (int m = gw; m < MP; m += NGW) {
        float ss = (lane < 32) ? PART[(size_t)m * 32 + lane] : 0.f;
        ss = wave_sum(ss);
        const float rstd = 1.0f / sqrtf(ss * (1.f / DM) + EPS);
        f32x4* y = (f32x4*)(F.out + O_Y + (size_t)m * DM); f32x4 v[8];
#pragma unroll
        for (int j = 0; j < 8; ++j) v[j] = y[lane + 64 * j];
#pragma unroll
        for (int j = 0; j < 8; ++j) { const f32x4 gv = ((const f32x4*)F.fin_g)[lane + 64 * j]; y[lane + 64 * j] = v[j] * rstd * gv; }
    }
    if (F.bid == F.G - 1) rms_row<true>(F.out + O_YS + (size_t)F.wave * DM, F.fin_g, F.out + O_YS + (size_t)F.wave * DM, lane);
}

constexpr int NPHASE = 7;
struct Args { const void* in[12]; float* out; unsigned char* ws; int ph_lo, ph_hi; };
__global__ void __launch_bounds__(NTHR, 2) hymba_fwd(Args args) {
    extern __shared__ __attribute__((aligned(16))) unsigned char lds_raw[];
    Frame F;
    F.lds = (LAS unsigned char*)lds_raw; F.MISC = (volatile LAS unsigned*)(F.lds + MISC_OFF);
    F.tid = threadIdx.x; F.lane = F.tid & 63; F.wave = __builtin_amdgcn_readfirstlane(F.tid >> 6); F.G = gridDim.x; F.bid = blockIdx.x;
    F.x = (const float*)args.in[0]; F.xs = (const float*)args.in[1]; F.cache_k = (const float*)args.in[2]; F.cache_v = (const float*)args.in[3]; F.cache_ki = (const float*)args.in[4];
    F.state = (const float*)args.in[5]; F.ptab = (const int*)args.in[6]; F.norm_g = (const float*)args.in[7]; F.w_in = (const float*)args.in[8]; F.ret_g = (const float*)args.in[9];
    F.w_out = (const float*)args.in[10]; F.fin_g = (const float*)args.in[11]; F.out = args.out; F.ws = args.ws; F.ctl = (unsigned*)(args.ws + WS_CTL);
    for (int u = F.tid; u < (LDS_BYTES - RING_BYTES) / 4; u += NTHR) ((LAS unsigned*)(F.lds + RING_BYTES))[u] = 0u;
    __syncthreads();
    const int lo = args.ph_lo, hi = args.ph_hi;
    const bool use_bar = (hi - lo) > 1;
    XcdBarrier bar; bar.bar = F.ctl + CW_BAR; bar.x = 0; bar.st = nullptr;
    if (use_bar) bar = xcd_barrier_post(F.ctl + CW_BAR, F.MISC + 8);
#ifndef PHASE_MASK
#define PHASE_MASK 0x7f
#endif
#define IN(k) (((PHASE_MASK >> (k)) & 1) && lo <= (k) && (k) < hi)
#define SEAM(k) do { if (IN(k) && IN((k) + 1)) xcd_barrier(bar); } while (0)
    const int g = F.bid;
    if (IN(0)) { p0_prologue(F); SEAM(0); }
    if (IN(1)) {
        p1_sample_gemv(F);
        pg8::Gemm gm{(const bf16_t*)(F.ws + WS_XN), (const bf16_t*)(F.ws + WS_WT), MP, DINP, DM}; pg8::StaticOrder S; S.init(MP, DINP, F.G, g);
        EpiInProj E{(bf16_t*)(F.ws + WS_QR), (bf16_t*)(F.ws + WS_KR), (bf16_t*)(F.ws + WS_VR), (bf16_t*)(F.ws + WS_GR), (bf16_t*)(F.ws + WS_QA), (bf16_t*)(F.ws + WS_KA), (bf16_t*)(F.ws + WS_VA),
                    (bf16_t*)(F.ws + WS_GA), (bf16_t*)(F.ws + WS_QI), (bf16_t*)(F.ws + WS_KI), (float*)(F.ws + WS_WI), F.out + O_NK, F.out + O_NV, F.out + O_NKI, (const float*)(F.ws + WS_CS)};
        pg8::gemm_phase<EpiInProj, pg8::StaticOrder, true, true>(F.lds, gm, S, E);
        SEAM(1);
    }
    if (IN(2)) {
        if (g == 64) { const float* ZS = (const float*)(F.ws + WS_ZS);
            for (int i = F.tid; i < DB * 256; i += NTHR) { const int b = i >> 8, k = i & 255; F.out[O_NKS + i] = ZS[(size_t)b * DIN + C_KA + k]; F.out[O_NVS + i] = ZS[(size_t)b * DIN + C_VA + k]; }
            for (int i = F.tid; i < DB * 128; i += NTHR) { const int b = i >> 7, k = i & 127; F.out[O_NKIS + i] = ZS[(size_t)b * DIN + C_KI + k]; } }
        p2_sample_scores(F);
        if (g < 64) p2_sample_retention(F, g >> 3, g & 7);
        __syncthreads();
        for (int u = g; u < 512; u += F.G) p2_retA_unit(F, u >> 4, u & 15);
        for (int bq = 0; bq < NB; ++bq) { const int j = (bq & 1) ? (255 - (g & 255)) : (g & 255); if (g < 256) p2_indexer_unit(F, bq, j); }
        SEAM(2);
    }
    if (IN(3)) {
        if (g < DB) p3_sample_attend(F, g);
        p3_scan(F);
        SEAM(3);
    }
    if (IN(4)) {
        for (int u = g; u < 512; u += F.G) p4_retB_unit(F, u >> 4, u & 15);
        if (g < 256) { const int b = g >> 6, jj = g & 63; p4_attn_unit(F, b, jj); p4_attn_unit(F, b, 127 - jj); }
        SEAM(4);
    }
    if (IN(5)) {
        p5_sample_outproj(F);
        pg8::Gemm gm{(const bf16_t*)(F.ws + WS_ACT), (const bf16_t*)(F.ws + WS_WOT), MP, DM, DM}; pg8::StaticOrder S; S.init(MP, DM, F.G, g);
        EpiOutProj E{F.x, F.out + O_Y, (float*)(F.ws + WS_PART)};
        pg8::gemm_phase<EpiOutProj, pg8::StaticOrder, false, true>(F.lds, gm, S, E);
        SEAM(5);
    }
    if (IN(6)) p6_final_norm(F);
#undef IN
#undef SEAM
}

extern "C" void kernel_launch(void* const* d_in, const int* in_sizes, int n_in, void* d_out, int out_size, void* d_ws, size_t ws_size, hipStream_t stream) {
    static int grid = 0;
    if (grid == 0) {
        if (n_in != 12 || ws_size < WS_END) { fprintf(stderr, "kernel_launch: unexpected inputs (n_in %d, ws %zu)\n", n_in, ws_size); grid = -1; return; }
        if (hipFuncSetAttribute((const void*)hymba_fwd, hipFuncAttributeMaxDynamicSharedMemorySize, LDS_BYTES) != hipSuccess) { fprintf(stderr, "kernel_launch: hipFuncSetAttribute failed\n"); grid = -1; return; }
        int dev = 0, cus = 0, per_cu = 0;
        hipGetDevice(&dev); hipDeviceGetAttribute(&cus, hipDeviceAttributeMultiprocessorCount, dev);
        hipOccupancyMaxActiveBlocksPerMultiprocessor(&per_cu, (const void*)hymba_fwd, NTHR, LDS_BYTES);
        (void)hipGetLastError();
        if (per_cu < 1) fprintf(stderr, "kernel_launch: occupancy query reports %d blocks per CU\n", per_cu);
        grid = 256;
        if (cus < 256) fprintf(stderr, "kernel_launch: device has %d CUs; this kernel needs 256 co-resident workgroups\n", cus);
    }
    if (grid < 0) return;
    (void)hipMemsetAsync((char*)d_ws + WS_CTL, 0, CTL_ZERO_BYTES, stream);
    Args a{};
    for (int i = 0; i < 12; ++i) a.in[i] = d_in[i];
    a.out = (float*)d_out; a.ws = (unsigned char*)d_ws;
    if (MK_N_LAUNCHES == 1) {
        a.ph_lo = 0; a.ph_hi = NPHASE;
        hipLaunchKernelGGL(hymba_fwd, dim3(grid), dim3(NTHR), LDS_BYTES, stream, a);
    } else {
        for (int p = 0; p < NPHASE; ++p) {
            int reps = 1;
#ifdef PROBE_DOUBLE
            if (p == PROBE_DOUBLE) reps = 2;
#endif
            for (int r = 0; r < reps; ++r) { a.ph_lo = p; a.ph_hi = p + 1; hipLaunchKernelGGL(hymba_fwd, dim3(grid), dim3(NTHR), LDS_BYTES, stream, a); }
        }
    }
}
```

```cpp
#include <hip/hip_runtime.h>
#include <cstdint>
#include <cstdio>

#define DI __device__ __forceinline__
#define LAS __attribute__((address_space(3)))
#define GAS __attribute__((address_space(1)))
typedef unsigned short bf16_t;
typedef short bf16x8 __attribute__((ext_vector_type(8)));
typedef short s16x4 __attribute__((ext_vector_type(4)));
typedef float f32x2 __attribute__((ext_vector_type(2)));
typedef float f32x4 __attribute__((ext_vector_type(4)));
typedef float f32x16 __attribute__((ext_vector_type(16)));
typedef unsigned u32x2 __attribute__((ext_vector_type(2)));
typedef unsigned u32x4 __attribute__((ext_vector_type(4)));
typedef __bf16 bf16x2_t __attribute__((ext_vector_type(2)));

#ifndef MK_N_LAUNCHES
#define MK_N_LAUNCHES 1
#endif

constexpr int DM = 2048, NB = 4, SEQ = 2048, MP = NB * SEQ  , DB = 8  , PAST = 16384, PAGE = 128, NPAGES = PAST / PAGE;
constexpr int HD = 128, NRH = 8, NAH = 8, NKV = 2, DKV = 256, NIH = 16, DIDX = 128, TOPK = 256, CH = 128  , NCH = SEQ / CH;
constexpr int DIN = 8848, DINP = 8960;
constexpr int C_QR = 0, C_KR = 1024, C_VR = 2048, C_GR = 3072, C_QA = 4096, C_KA = 5120, C_VA = 5376, C_GA = 5632, C_QI = 6656, C_KI = 8704, C_WI = 8832;
constexpr float EPS = 1e-6f;
constexpr float KSCALE = 0.08838834764831845f;
constexpr float QA_SCALE = 0.08838834764831845f * 1.4426950408889634f;
constexpr float WI_SCALE = 0.022097086912079608f;
constexpr size_t O_Y = 0, O_YS = 16777216, O_NK = 16793600, O_NV = 18890752, O_NKI = 20987904, O_ST = 22036480, O_NKS = 22560768, O_NVS = 22562816, O_NKIS = 22564864, O_STS = 22565888;
constexpr size_t MiB = 1u << 20;
constexpr size_t WS_CTL = 0, CTL_ZERO_BYTES = 1 * MiB;
constexpr size_t WS_WT = 2 * MiB;
constexpr size_t WS_WOT = 40 * MiB;
constexpr size_t WS_XN = 48 * MiB;
constexpr size_t WS_QR = 80 * MiB;
constexpr size_t WS_KR = 96 * MiB, WS_VR = 112 * MiB, WS_GR = 128 * MiB, WS_QA = 144 * MiB, WS_GA = 160 * MiB;
constexpr size_t WS_KA = 176 * MiB;
constexpr size_t WS_VA = 180 * MiB;
constexpr size_t WS_QI = 184 * MiB;
constexpr size_t WS_KI = 216 * MiB;
constexpr size_t WS_WI = 218 * MiB;
constexpr size_t WS_CS = 219 * MiB;
constexpr size_t WS_XNS = 221 * MiB;
constexpr size_t WS_ZS = 222 * MiB;
constexpr size_t WS_ACTS = 223 * MiB;
constexpr size_t WS_SCS = 224 * MiB;
constexpr size_t WS_PART = 225 * MiB;
constexpr size_t WS_MASK = 226 * MiB;
constexpr size_t WS_KV = 228 * MiB;
constexpr size_t WS_SP = 260 * MiB;
constexpr size_t WS_ACT = 276 * MiB;
constexpr size_t WS_HP = 308 * MiB;
constexpr size_t WS_HPS = 372 * MiB;
constexpr size_t WS_END = 373 * MiB;

__device__ const float ROPE_INV[64] = {
1.f, 0.865964353f, 0.749894261f, 0.649381638f, 0.562341332f, 0.486967534f, 0.421696514f, 0.365174115f, 0.316227764f, 0.273841977f, 0.237137377f, 0.2053525f, 0.177827939f, 0.153992653f, 0.133352131f, 0.115478203f,
0.100000001f, 0.0865964293f, 0.0749894157f, 0.0649381652f, 0.0562341325f, 0.0486967526f, 0.0421696529f, 0.0365174115f, 0.0316227749f, 0.0273841973f, 0.0237137377f, 0.0205352511f, 0.0177827943f, 0.0153992651f, 0.0133352149f, 0.0115478206f,
0.00999999978f, 0.00865964312f, 0.00749894185f, 0.00649381615f, 0.00562341325f, 0.00486967526f, 0.00421696482f, 0.00365174119f, 0.00316227763f, 0.00273841969f, 0.00237137359f, 0.00205352483f, 0.00177827943f, 0.00153992651f, 0.00133352145f, 0.0011547819f,
0.00100000005f, 0.000865964335f, 0.000749894243f, 0.000649381662f, 0.000562341302f, 0.000486967532f, 0.000421696517f, 0.000365174143f, 0.000316227757f, 0.000273841957f, 0.00023713737f, 0.00020535251f, 0.00017782794f, 0.000153992645f, 0.00013335215f, 0.0001154782f};
DI float l2g(int h) {
    const float t[8] = {-0.04580368961312479f, -0.02272007650008353f, -0.011315313227834146f, -0.005646563141142063f, -0.0028205190623786626f, -0.0014095702546713536f, -0.0007046129765893727f, -0.0003522634716290214f};
    float r = t[0];
#pragma unroll
    for (int i = 1; i < 8; ++i) r = (h == i) ? t[i] : r;
    return r;
}

#define LDS_WAIT() asm volatile("s_waitcnt lgkmcnt(0)" ::: "memory")
#define VM_WAIT() asm volatile("s_waitcnt vmcnt(0)" ::: "memory")
DI unsigned cvtpk(float lo, float hi) { f32x2 v = {lo, hi}; bf16x2_t b = __builtin_convertvector(v, bf16x2_t); return __builtin_bit_cast(unsigned, b); }
DI float bf2f(unsigned short b) { return __uint_as_float((unsigned)b << 16); }
DI float bflo(unsigned w) { return __uint_as_float(w << 16); }
DI float bfhi(unsigned w) { return __uint_as_float(w & 0xffff0000u); }
DI float wave_sum(float v) {
#pragma unroll
    for (int o = 1; o < 64; o <<= 1) v += __shfl_xor(v, o);
    return v;
}
DI float silu(float x) { return x / (1.f + __expf(-x)); }
DI unsigned fkey(float s) { const unsigned b = __float_as_uint(s); return (b & 0x80000000u) ? ~b : (b | 0x80000000u); }

namespace pg8 {
constexpr int BM = 256, BK = 64, HALF = 128, HTB = HALF * BK * 2, STAGE_BYTES = 8 * HTB, NXCD = 8, WGM = 8;
DI int lds_byte(int r, int c) { const int st = (r >> 4) * 2 + (c >> 5), rr = r & 15, cc = c & 31, ob = rr * 64 + cc * 2; return st * 1024 + (ob ^ (((ob >> 9) & 1) << 5)); }
DI void stage_rc(int b, int& R, int& C) { const int st = b / 1024, sb = b % 1024, swz = sb ^ (((sb >> 9) & 1) << 5); R = (st >> 1) * 16 + swz / 64; C = (st & 1) * 32 + (swz % 64) / 2; }
DI int perm32(int rho) { const int n = rho >> 4, i = rho & 15; return 8 * (i >> 2) + 4 * n + (i & 3); }
struct Unit { int pm, pn; };
struct Gemm { const bf16_t* A; const bf16_t* Bt; int M, N, K; };
struct StaticOrder {
    int nM, nN, nwg, G, c;
    DI void init(int M, int N, int G_, int c_) { nM = M / BM; nN = N / BM; nwg = nM * nN; G = G_; c = c_; }
    DI bool next(int i, Unit& u) const {
        const long L = (long)i * G + c; if (L >= nwg) return false;
        int wgid = (int)L; { const int q = nwg / NXCD, r = nwg % NXCD, xcd = wgid % NXCD, off = wgid / NXCD; wgid = (xcd < r ? xcd * (q + 1) : r * (q + 1) + (xcd - r) * q) + off; }
        const int nig = WGM * nN, gid = wgid / nig, fm = gid * WGM, gsz = (nM - fm) < WGM ? (nM - fm) : WGM;
        u.pm = fm + ((wgid % nig) % gsz); u.pn = (wgid % nig) / gsz; return true;
    }
    DI void a_ready(const Unit&) const {}
    DI void done(const Unit&) const {}
};

template <class Epi, class Sched, bool ALIGN_EPI = false, bool SP2 = false>
DI void gemm_phase(LAS unsigned char* lds, const Gemm g, const Sched& S, const Epi& E) {
    const int tid = threadIdx.x, wid = __builtin_amdgcn_readfirstlane(tid >> 6), lane = tid & 63, wr = wid >> 2, wc = wid & 3, fr = lane & 15, fq = lane >> 4;
    const int K = g.K, nt = K / BK;
    unsigned voffA[2], voffB[2];
#pragma unroll
    for (int i = 0; i < 2; ++i) { int R, C; stage_rc(tid * 16 + i * 8192, R, C); const int Rb = Epi::PERM ? ((R & ~31) + perm32(R & 31)) : R;
        voffA[i] = (unsigned)(R * K + C) * 2u; voffB[i] = (unsigned)(Rb * K + C) * 2u; }
    const size_t kstep = (size_t)(BK * 2);
    const size_t hstep = (size_t)HALF * K * 2;
    const size_t tstep = 2 * hstep;
    const unsigned ldsw = (unsigned)wid * 1024u;
    const int aoff = lds_byte(wr * 64 + fr, fq * 8), boff = lds_byte(wc * 32 + fr, fq * 8);
#define PG8_SA(b, h) (((b) * 2 + (h)) * HTB)
#define PG8_SB(b, h) ((4 + (b) * 2 + (h)) * HTB)
#define PG8_STAGE(bufoff, gbase, voff) do { _Pragma("unroll") for (int _i = 0; _i < 2; ++_i) \
        __builtin_amdgcn_global_load_lds((const unsigned*)((const char*)(gbase) + (voff)[_i]), (LAS unsigned*)(lds + (bufoff) + ldsw + _i * 8192), 16, 0, 0); } while (0)
#define PG8_LDA(dst, b, h) do { _Pragma("unroll") for (int m = 0; m < 4; ++m) _Pragma("unroll") for (int k = 0; k < 2; ++k) dst[m][k] = *(const LAS bf16x8*)(lds + PG8_SA(b, h) + aoff + m * 2048 + k * 1024); } while (0)
#define PG8_LDB(dst, b, h) do { _Pragma("unroll") for (int n = 0; n < 2; ++n) _Pragma("unroll") for (int k = 0; k < 2; ++k) dst[n][k] = *(const LAS bf16x8*)(lds + PG8_SB(b, h) + boff + n * 2048 + k * 1024); } while (0)
#define PG8_MMA(ai, bj, At, Bt) do { __builtin_amdgcn_s_setprio(1); _Pragma("unroll") for (int m = 0; m < 4; ++m) _Pragma("unroll") for (int n = 0; n < 2; ++n) _Pragma("unroll") for (int k = 0; k < 2; ++k) \
        acc[ai][bj][m][n] = __builtin_amdgcn_mfma_f32_16x16x32_bf16(Bt[n][k], At[m][k], acc[ai][bj][m][n], 0, 0, 0); __builtin_amdgcn_s_setprio(0); } while (0)
#define PG8_WAIT_V(n) asm volatile("s_waitcnt vmcnt(" #n ")" ::: "memory")
#define PG8_WAIT_L(n) asm volatile("s_waitcnt lgkmcnt(" #n ")" ::: "memory")
#define PG8_BAR __builtin_amdgcn_s_barrier()
#define PG8_SCHED __builtin_amdgcn_sched_barrier(0)
    Unit cur, nxt; int ui = 0;
    if (!S.next(0, cur)) return;
    f32x4 acc[2][2][4][2];
#pragma unroll
    for (int a = 0; a < 2; ++a)
#pragma unroll
        for (int b = 0; b < 2; ++b)
#pragma unroll
            for (int m = 0; m < 4; ++m)
#pragma unroll
                for (int n = 0; n < 2; ++n) acc[a][b][m][n] = (f32x4){0.f, 0.f, 0.f, 0.f};
    bf16x8 At[4][2], B0[2][2], B1[2][2];
    const char* cA = (const char*)g.A + (size_t)cur.pm * tstep; const char* cB = (const char*)g.Bt + (size_t)cur.pn * tstep;
    S.a_ready(cur);
    if constexpr (SP2) {
        PG8_STAGE(PG8_SB(0, 0), cB, voffB); PG8_STAGE(PG8_SB(0, 1), cB + hstep, voffB); PG8_STAGE(PG8_SA(0, 0), cA, voffA); PG8_STAGE(PG8_SA(0, 1), cA + hstep, voffA);
        if (wr == 1) PG8_BAR;
        PG8_WAIT_V(2); PG8_BAR;
        PG8_STAGE(PG8_SB(1, 0), cB + kstep, voffB); PG8_STAGE(PG8_SA(1, 0), cA + kstep, voffA); PG8_STAGE(PG8_SB(1, 1), cB + hstep + kstep, voffB);
        PG8_WAIT_V(6); PG8_BAR;
    } else {
        PG8_STAGE(PG8_SB(0, 0), cB, voffB); PG8_STAGE(PG8_SA(0, 0), cA, voffA); PG8_STAGE(PG8_SB(0, 1), cB + hstep, voffB); PG8_STAGE(PG8_SA(0, 1), cA + hstep, voffA);
        if (wr == 1) PG8_BAR;
        PG8_WAIT_V(4); PG8_BAR;
        PG8_STAGE(PG8_SB(1, 0), cB + kstep, voffB); PG8_STAGE(PG8_SA(1, 0), cA + kstep, voffA); PG8_STAGE(PG8_SB(1, 1), cB + hstep + kstep, voffB);
        PG8_WAIT_V(6); PG8_BAR;
    }
    for (;;) {
        const bool has_next = S.next(ui + 1, nxt);
        const char* nA = has_next ? (const char*)g.A + (size_t)nxt.pm * tstep : cA; const char* nB = has_next ? (const char*)g.Bt + (size_t)nxt.pn * tstep : cB;
        for (int t = 0; t < nt; t += 2) {
            const bool last = (t == nt - 2);
            const char* a1 = cA + (size_t)(t + 1) * kstep;
            const char* a2 = last ? nA : cA + (size_t)(t + 2) * kstep; const char* b2 = last ? nB : cB + (size_t)(t + 2) * kstep;
            const char* a3 = a2 + kstep; const char* b3 = b2 + kstep;
            if (last && has_next) S.a_ready(nxt);
            if constexpr (SP2) {
            PG8_LDB(B0, 0, 0); PG8_LDB(B1, 0, 1); PG8_SCHED; PG8_LDA(At, 0, 0); PG8_STAGE(PG8_SA(1, 1), a1 + hstep, voffA);
            PG8_WAIT_V(8); PG8_WAIT_L(0); PG8_BAR; PG8_MMA(0, 0, At, B0); PG8_MMA(0, 1, At, B1); PG8_BAR; PG8_SCHED;
            PG8_LDA(At, 0, 1); PG8_STAGE(PG8_SB(0, 0), b2, voffB); PG8_STAGE(PG8_SB(0, 1), b2 + hstep, voffB); PG8_STAGE(PG8_SA(0, 0), a2, voffA);
            PG8_WAIT_V(8); PG8_WAIT_L(0); PG8_BAR; PG8_MMA(1, 0, At, B0); PG8_MMA(1, 1, At, B1); PG8_BAR; PG8_SCHED;
            PG8_LDB(B0, 1, 0); PG8_LDB(B1, 1, 1); PG8_SCHED; PG8_LDA(At, 1, 0); PG8_STAGE(PG8_SA(0, 1), a2 + hstep, voffA);
            PG8_WAIT_V(8); PG8_WAIT_L(0); PG8_BAR; PG8_MMA(0, 0, At, B0); PG8_MMA(0, 1, At, B1); PG8_BAR; PG8_SCHED;
            PG8_LDA(At, 1, 1); PG8_STAGE(PG8_SB(1, 0), b3, voffB); PG8_STAGE(PG8_SB(1, 1), b3 + hstep, voffB); PG8_STAGE(PG8_SA(1, 0), a3, voffA);
            PG8_WAIT_V(8); PG8_WAIT_L(0); PG8_BAR; PG8_MMA(1, 0, At, B0); PG8_MMA(1, 1, At, B1); PG8_BAR; PG8_SCHED;
            } else {
            PG8_LDB(B0, 0, 0); PG8_SCHED; PG8_LDA(At, 0, 0); PG8_STAGE(PG8_SA(1, 1), a1 + hstep, voffA);
            PG8_WAIT_L(8); PG8_BAR; PG8_WAIT_L(0); PG8_MMA(0, 0, At, B0); PG8_BAR; PG8_SCHED;
            PG8_LDB(B1, 0, 1); PG8_STAGE(PG8_SB(0, 0), b2, voffB);
            PG8_BAR; PG8_WAIT_L(0); PG8_MMA(0, 1, At, B1); PG8_BAR;
            PG8_LDA(At, 0, 1); PG8_STAGE(PG8_SA(0, 0), a2, voffA);
            PG8_BAR; PG8_WAIT_L(0); PG8_MMA(1, 0, At, B0); PG8_BAR; PG8_SCHED;
            PG8_STAGE(PG8_SB(0, 1), b2 + hstep, voffB);
            PG8_WAIT_V(6); PG8_BAR; PG8_MMA(1, 1, At, B1); PG8_BAR;
            PG8_LDB(B0, 1, 0); PG8_SCHED; PG8_LDA(At, 1, 0); PG8_STAGE(PG8_SA(0, 1), a2 + hstep, voffA);
            PG8_WAIT_L(8); PG8_BAR; PG8_WAIT_L(0); PG8_MMA(0, 0, At, B0); PG8_BAR; PG8_SCHED;
            PG8_LDB(B1, 1, 1); PG8_STAGE(PG8_SB(1, 0), b3, voffB);
            PG8_BAR; PG8_WAIT_L(0); PG8_MMA(0, 1, At, B1); PG8_BAR;
            PG8_LDA(At, 1, 1); PG8_STAGE(PG8_SA(1, 0), a3, voffA);
            PG8_BAR; PG8_WAIT_L(0); PG8_MMA(1, 0, At, B0); PG8_BAR; PG8_SCHED;
            PG8_STAGE(PG8_SB(1, 1), b3 + hstep, voffB);
            PG8_WAIT_V(6); PG8_BAR; PG8_MMA(1, 1, At, B1); PG8_BAR;
            }
        }
        if constexpr (ALIGN_EPI) { if (wr == 0) PG8_BAR; }
        if constexpr (!Epi::AFTER_DRAIN) { E(acc, cur, wr, wc, fr, fq); S.done(cur); }
        if (!has_next) break;
#pragma unroll
        for (int a = 0; a < 2; ++a)
#pragma unroll
            for (int b = 0; b < 2; ++b)
#pragma unroll
                for (int m = 0; m < 4; ++m)
#pragma unroll
                    for (int n = 0; n < 2; ++n) acc[a][b][m][n] = (f32x4){0.f, 0.f, 0.f, 0.f};
        cur = nxt; cA = nA; cB = nB; ++ui;
        if constexpr (ALIGN_EPI) { if (wr == 1) PG8_BAR; }
    }
    PG8_WAIT_V(0);
    if constexpr (!ALIGN_EPI) { if (wr == 0) PG8_BAR; }
    PG8_BAR;
#undef PG8_SA
#undef PG8_SB
#undef PG8_STAGE
#undef PG8_LDA
#undef PG8_LDB
#undef PG8_MMA
#undef PG8_WAIT_V
#undef PG8_WAIT_L
#undef PG8_BAR
#undef PG8_SCHED
}
}

DI int cmap_in(int c) {
    if (c >= DIN) return -1;
    if (c >= C_VR) return c;
    const int hb = c & ~127, s = c & 127, g = s >> 3, e = s & 7;
    return hb + ((e < 4) ? (4 * g + e) : (64 + 4 * g + (e - 4)));
}

struct EpiInProj {
    static constexpr bool PERM = true, AFTER_DRAIN = false;
    bf16_t *QR, *KR, *VR, *GR, *QA, *KA, *VA, *GA, *QI, *KI; float* WI; float *oK, *oV, *oKI; const float* CS;
    DI void operator()(const f32x4 (&acc)[2][2][4][2], const pg8::Unit& u, int wr, int wc, int fr, int fq) const {
        const int pn = u.pn, rowb = u.pm * 256 + wr * 64 + fr, cl = wc * 32 + 8 * fq;
        if (pn < 8) {
            const bool isq = pn < 4; bf16_t* dst = isq ? QR : KR; const int g4 = 4 * (4 * wc + fq);
#pragma unroll
            for (int ai = 0; ai < 2; ++ai)
#pragma unroll
                for (int m = 0; m < 4; ++m) {
                    const int row = rowb + ai * 128 + m * 16, pos = row & (SEQ - 1), ic = pos & (CH - 1);
                    const f32x4 cs = *(const f32x4*)(CS + (size_t)pos * 128 + g4), sn = *(const f32x4*)(CS + (size_t)pos * 128 + 64 + g4);
#pragma unroll
                    for (int bj = 0; bj < 2; ++bj) {
                        const int head = 2 * (pn & 3) + bj;
                        const float lg = l2g(head) * (float)(ic + 1);
                        const float sc = isq ? __builtin_amdgcn_exp2f(lg) : KSCALE * __builtin_amdgcn_exp2f(-lg);
                        const f32x4 x1 = acc[ai][bj][m][0], x2 = acc[ai][bj][m][1];
                        const f32x4 o1 = (x1 * cs - x2 * sn) * sc, o2 = (x1 * sn + x2 * cs) * sc;
                        bf16_t* p = dst + (size_t)row * 1024 + head * 128 + g4;
                        *(u32x2*)p = (u32x2){cvtpk(o1[0], o1[1]), cvtpk(o1[2], o1[3])};
                        *(u32x2*)(p + 64) = (u32x2){cvtpk(o2[0], o2[1]), cvtpk(o2[2], o2[3])};
                    }
                }
            return;
        }
        int kind; bf16_t* bdst = nullptr; int ld = 0, cbase = 0; float* fdst = nullptr; int fld = 0;
        if (pn < 12) { kind = 0; bdst = VR; ld = 1024; cbase = (pn - 8) * 256; }
        else if (pn < 16) { kind = 1; bdst = GR; ld = 1024; cbase = (pn - 12) * 256; }
        else if (pn < 20) { kind = 2; bdst = QA; ld = 1024; cbase = (pn - 16) * 256; }
        else if (pn == 20) { kind = 3; bdst = KA; ld = 256; cbase = 0; fdst = oK; fld = 256; }
        else if (pn == 21) { kind = 3; bdst = VA; ld = 256; cbase = 0; fdst = oV; fld = 256; }
        else if (pn < 26) { kind = 1; bdst = GA; ld = 1024; cbase = (pn - 22) * 256; }
        else if (pn < 34) { kind = 0; bdst = QI; ld = 2048; cbase = (pn - 26) * 256; }
        else { kind = 4; }
#pragma unroll
        for (int ai = 0; ai < 2; ++ai)
#pragma unroll
            for (int m = 0; m < 4; ++m) {
                const int row = rowb + ai * 128 + m * 16;
#pragma unroll
                for (int bj = 0; bj < 2; ++bj) {
                    f32x4 v0 = acc[ai][bj][m][0], v1 = acc[ai][bj][m][1];
                    const int col = bj * 128 + cl;
                    if (kind == 4) {
                        if (bj == 0) {
                            *(f32x4*)(oKI + (size_t)row * 128 + col) = v0; *(f32x4*)(oKI + (size_t)row * 128 + col + 4) = v1;
                            *(u32x4*)(KI + (size_t)row * 128 + col) = (u32x4){cvtpk(v0[0], v0[1]), cvtpk(v0[2], v0[3]), cvtpk(v1[0], v1[1]), cvtpk(v1[2], v1[3])};
                        } else if (cl < 16) {
                            *(f32x4*)(WI + (size_t)row * 16 + cl) = v0 * WI_SCALE; *(f32x4*)(WI + (size_t)row * 16 + cl + 4) = v1 * WI_SCALE;
                        }
                        continue;
                    }
                    if (kind == 3) { *(f32x4*)(fdst + (size_t)row * fld + col) = v0; *(f32x4*)(fdst + (size_t)row * fld + col + 4) = v1; }
                    if (kind == 1) {
#pragma unroll
                        for (int e = 0; e < 4; ++e) { v0[e] = silu(v0[e]); v1[e] = silu(v1[e]); }
                    }
                    if (kind == 2) { v0 = v0 * QA_SCALE; v1 = v1 * QA_SCALE; }
                    *(u32x4*)(bdst + (size_t)row * ld + cbase + col) = (u32x4){cvtpk(v0[0], v0[1]), cvtpk(v0[2], v0[3]), cvtpk(v1[0], v1[1]), cvtpk(v1[2], v1[3])};
                }
            }
    }
};

struct EpiOutProj {
    static constexpr bool PERM = false, AFTER_DRAIN = false;
    const float* X; float* Y; float* PART;
    DI void operator()(const f32x4 (&acc)[2][2][4][2], const pg8::Unit& u, int wr, int wc, int fr, int fq) const {
        const int rowb = u.pm * 256 + wr * 64 + fr, col0 = u.pn * 256 + wc * 32 + 4 * fq;
#pragma unroll
        for (int ai = 0; ai < 2; ++ai)
#pragma unroll
            for (int m = 0; m < 4; ++m) {
                const int row = rowb + ai * 128 + m * 16; float ss = 0.f;
#pragma unroll
                for (int bj = 0; bj < 2; ++bj)
#pragma unroll
                    for (int n = 0; n < 2; ++n) {
                        const size_t off = (size_t)row * DM + col0 + bj * 128 + n * 16;
                        const f32x4 h = *(const f32x4*)(X + off) + acc[ai][bj][m][n];
                        *(f32x4*)(Y + off) = h; ss += (h[0] * h[0] + h[1] * h[1]) + (h[2] * h[2] + h[3] * h[3]);
                    }
                ss += __shfl_xor(ss, 16); ss += __shfl_xor(ss, 32);
                if (fq == 0) PART[(size_t)row * 32 + u.pn * 4 + wc] = ss;
            }
    }
};

DI unsigned tile_off(unsigned row, unsigned ch) { return 256u * row + 16u * (ch ^ (((row & 3) << 2) | ((row >> 2) & 3))); }
DI unsigned vtile_off(unsigned row, unsigned ch) { return 256u * row + 16u * (ch ^ (((row & 3) << 2) | (((row >> 2) & 1) << 1))); }
typedef short v4i16_t __attribute__((ext_vector_type(4)));
DI s16x4 tr4(const LAS char* p) { return __builtin_bit_cast(s16x4, __builtin_amdgcn_ds_read_tr16_b64_v4i16((LAS v4i16_t*)p)); }
DI bf16x8 row_frag(const LAS char* img, int row0, int lane, int s) { return *(const LAS bf16x8*)(img + tile_off(row0 + (lane & 31), 2 * s + (lane >> 5))); }
DI bf16x8 tr_frag(const LAS char* img, int krow0, int col0, int lane) {
    const unsigned h = lane >> 5, blk = (lane >> 4) & 1, q = (lane & 15) >> 2, p = lane & 3, ch = (col0 >> 3) + 2 * blk + (p >> 1);
    const s16x4 lo = tr4(img + tile_off(krow0 + 8 * h + q, ch) + 8 * (p & 1)), hi = tr4(img + tile_off(krow0 + 8 * h + 4 + q, ch) + 8 * (p & 1));
    return __builtin_shufflevector(lo, hi, 0, 1, 2, 3, 4, 5, 6, 7);
}
DI bf16x8 tr_frag_perm(const LAS char* img, int krow0, int col0, int lane) {
    const unsigned h = lane >> 5, blk = (lane >> 4) & 1, q = (lane & 15) >> 2, p = lane & 3, ch = (col0 >> 3) + 2 * blk + (p >> 1);
    const s16x4 lo = tr4(img + tile_off(krow0 + 4 * h + q, ch) + 8 * (p & 1)), hi = tr4(img + tile_off(krow0 + 8 + 4 * h + q, ch) + 8 * (p & 1));
    return __builtin_shufflevector(lo, hi, 0, 1, 2, 3, 4, 5, 6, 7);
}
DI bf16x8 row_frag16(const LAS char* img, int row0, int lane, int s) { return *(const LAS bf16x8*)(img + tile_off(row0 + (lane & 15), 4 * s + (lane >> 4))); }
DI bf16x8 tr16_perm(const LAS char* img, int krow0, int c8, int lane) {
    const unsigned g = lane >> 4, q = (lane & 15) >> 2, p = lane & 3, ch = 2 * c8 + (p >> 1);
    const s16x4 lo = tr4(img + vtile_off(krow0 + 4 * g + q, ch) + 8 * (p & 1)), hi = tr4(img + vtile_off(krow0 + 16 + 4 * g + q, ch) + 8 * (p & 1));
    return __builtin_shufflevector(lo, hi, 0, 1, 2, 3, 4, 5, 6, 7);
}
template <int NROWS, bool VT> DI void load_tile(LAS char* img, const char* g, size_t gstride, int tid) {
#pragma unroll
    for (int i = 0; i < NROWS * 16 / 512; ++i) {
        const int n = tid + 512 * i, row = n >> 4, ch = n & 15;
        const u32x4 v = *(const u32x4*)(g + (size_t)row * gstride + ch * 16);
        *(LAS u32x4*)(img + (VT ? vtile_off(row, ch) : tile_off(row, ch))) = v;
    }
}
template <int NROWS> DI void tile_fetch(u32x4 (&v)[NROWS * 16 / 512], const char* g, size_t gstride, int tid) {
#pragma unroll
    for (int i = 0; i < NROWS * 16 / 512; ++i) { const int n = tid + 512 * i, row = n >> 4, ch = n & 15; v[i] = *(const u32x4*)(g + (size_t)row * gstride + ch * 16); }
}
template <int NROWS, bool VT> DI void tile_put(LAS char* img, const u32x4 (&v)[NROWS * 16 / 512], int tid) {
#pragma unroll
    for (int i = 0; i < NROWS * 16 / 512; ++i) { const int n = tid + 512 * i, row = n >> 4, ch = n & 15; *(LAS u32x4*)(img + (VT ? vtile_off(row, ch) : tile_off(row, ch))) = v[i]; }
}
DI f32x16 zero16() { f32x16 z;
#pragma unroll
    for (int i = 0; i < 16; ++i) z[i] = 0.f;
    return z; }
DI int crow(int r, int h) { return (r & 3) + 8 * (r >> 2) + 4 * h; }
#define MFMA32(a, b, c) __builtin_amdgcn_mfma_f32_32x32x16_bf16((a), (b), (c), 0, 0, 0)
#define MFMA16(a, b, c) __builtin_amdgcn_mfma_f32_16x16x32_bf16((a), (b), (c), 0, 0, 0)

constexpr int NWAVES = 8, NTHR = 512;
constexpr int RING_BYTES = 131072, MISC_OFF = RING_BYTES + 320, LDS_BYTES = 147456;
struct Frame {
    LAS unsigned char* lds; volatile LAS unsigned* MISC; unsigned* ctl;
    int tid, lane, wave, G, bid;
    const float *x, *xs, *cache_k, *cache_v, *cache_ki, *state, *norm_g, *w_in, *ret_g, *w_out, *fin_g; const int* ptab;
    float* out; unsigned char* ws;
};

#define XB_TMO      128
#define XB_XCNT(j)  (256  + 64 * (j))
#define XB_XSUB(j)  (1280 + 64 * (j))
#define XB_XGEN(j)  (2304 + 64 * (j))
#define XB_TOP      3328
#define XB_TOPGEN   3392
#define XCD_BAR_WORDS 3456
#define XB_SPIN_CAP (1u << 20)
constexpr int CW_BAR = 4096;
DI unsigned xb_ld(unsigned* p) { return __hip_atomic_load(p, __ATOMIC_RELAXED, __HIP_MEMORY_SCOPE_AGENT); }
DI unsigned xb_add(unsigned* p, unsigned v) { return __hip_atomic_fetch_add(p, v, __ATOMIC_RELAXED, __HIP_MEMORY_SCOPE_AGENT); }
DI unsigned xb_xcc_id() { return (unsigned)__builtin_amdgcn_s_getreg((3 << 11) | 20) & 0xFu; }
#define XB_SPIN(cond, bar) do { unsigned _sp = 0; while (cond) { __builtin_amdgcn_s_sleep(1); \
    if ((++_sp & 255u) == 0u) { if (xb_ld(&(bar)[XB_TMO])) break; if (_sp > XB_SPIN_CAP) { atomicAdd(&(bar)[XB_TMO], 1u); break; } } } } while (0)
struct XcdBarrier { unsigned* bar; unsigned x; volatile LAS unsigned* st; };
DI XcdBarrier xcd_barrier_post(unsigned* bar, volatile LAS unsigned* st) {
    XcdBarrier b; b.bar = bar; b.x = xb_xcc_id(); b.st = st;
    if (threadIdx.x == 0) (void)xb_add(&bar[XB_XCNT(b.x)], 1u);
    return b;
}
DI void xcd_barrier_complete(unsigned* bar, unsigned x, unsigned& nloc, unsigned& nx) {
    const unsigned G = gridDim.x * gridDim.y * gridDim.z;
    unsigned sum, cnt, mine, sp = 0u;
    for (;;) {
        sum = 0u; cnt = 0u; mine = 0u;
#pragma unroll
        for (unsigned j = 0; j < 16; ++j) { const unsigned c = xb_ld(&bar[XB_XCNT(j)]); sum += c; cnt += (c > 0u) ? 1u : 0u; mine = (j == x) ? c : mine; }
        if (sum == G) break;
        __builtin_amdgcn_s_sleep(1);
        if ((++sp & 255u) == 0u) { if (xb_ld(&bar[XB_TMO])) break; if (sp > XB_SPIN_CAP) { atomicAdd(&bar[XB_TMO], 1u); break; } }
    }
    nloc = mine > 0u ? mine : 1u; nx = cnt > 0u ? cnt : 1u;
}
DI void xcd_barrier(const XcdBarrier& b) {
    asm volatile("s_waitcnt vmcnt(0)" ::: "memory");
    __syncthreads();
    if (threadIdx.x == 0) {
        unsigned* bar = b.bar;
        __builtin_amdgcn_s_waitcnt(0);
        unsigned nloc = b.st[0], nx = b.st[1];
        if (nloc == 0u) { xcd_barrier_complete(bar, b.x, nloc, nx); b.st[0] = nloc; b.st[1] = nx; }
        const unsigned old = xb_add(&bar[XB_XSUB(b.x)], 1u);
        const unsigned gen = old / nloc;
        if (old + 1u == (gen + 1u) * nloc) {
            __builtin_amdgcn_fence(__ATOMIC_RELEASE, "agent");
            asm volatile("s_waitcnt vmcnt(0)" ::: "memory");
            const unsigned og = xb_add(&bar[XB_TOP], 1u);
            const unsigned tg = og / nx;
            if (og + 1u == (tg + 1u) * nx) xb_add(&bar[XB_TOPGEN], 1u);
            else XB_SPIN(xb_ld(&bar[XB_TOPGEN]) == tg, bar);
            __builtin_amdgcn_fence(__ATOMIC_ACQUIRE, "agent");
            xb_add(&bar[XB_XGEN(b.x)], 1u);
            asm volatile("s_waitcnt vmcnt(0)" ::: "memory");
        } else {
            XB_SPIN(xb_ld(&bar[XB_XGEN(b.x)]) == gen, bar);
            __builtin_amdgcn_fence(__ATOMIC_ACQUIRE, "agent");
            asm volatile("s_waitcnt vmcnt(0)" ::: "memory");
        }
    }
    __syncthreads();
}

template <class CMap> DI void p0_transpose_item(const float* W, int K, int ldw, bf16_t* WT, LAS float* scr, int item, int nblk, int lane, CMap cm) {
    const int kb = item / nblk, nb = item % nblk, k0 = 64 * kb, n0 = 32 * nb;
    const int col = cm(n0 + (lane & 31));
#pragma unroll 8
    for (int i = 0; i < 32; ++i) { const int kk = 2 * i + (lane >> 5); scr[kk * 33 + (lane & 31)] = (col >= 0) ? W[(size_t)(k0 + kk) * ldw + col] : 0.f; }
    LDS_WAIT(); asm volatile("" ::: "memory");
    const int c = lane & 7;
#pragma unroll
    for (int j = 0; j < 4; ++j) { const int n = (lane >> 3) + 8 * j; const LAS float* s = scr + (8 * c) * 33 + n;
        u32x4 o; o.x = cvtpk(s[0 * 33], s[1 * 33]); o.y = cvtpk(s[2 * 33], s[3 * 33]); o.z = cvtpk(s[4 * 33], s[5 * 33]); o.w = cvtpk(s[6 * 33], s[7 * 33]);
        *(u32x4*)(WT + (size_t)(n0 + n) * K + k0 + 8 * c) = o; }
    LDS_WAIT(); asm volatile("" ::: "memory");
}
template <bool OUTF> DI void rms_row(const float* xrow, const float* g, void* orow, int lane) {
    const f32x4* xr = (const f32x4*)xrow + lane; f32x4 v[8]; float s = 0.f;
#pragma unroll
    for (int j = 0; j < 8; ++j) { v[j] = xr[64 * j]; s += (v[j][0] * v[j][0] + v[j][1] * v[j][1]) + (v[j][2] * v[j][2] + v[j][3] * v[j][3]); }
    const float rstd = 1.0f / sqrtf(wave_sum(s) * (1.f / DM) + EPS);
#pragma unroll
    for (int j = 0; j < 8; ++j) { const f32x4 gv = ((const f32x4*)g)[lane + 64 * j]; const f32x4 o = v[j] * rstd * gv;
        if (OUTF) ((f32x4*)orow)[lane + 64 * j] = o;
        else ((u32x2*)orow)[lane + 64 * j] = (u32x2){cvtpk(o[0], o[1]), cvtpk(o[2], o[3])}; }
}
DI void rope_entry(float* CS, int idx) {
    const int p = idx >> 6, i = idx & 63; const float pos = (p == SEQ) ? (float)PAST : (float)p;
    const float ang = pos * ROPE_INV[i];
    const double a = (double)ang, q = __builtin_rint(a * 0.63661977236758134308);
    double r = __builtin_fma(-q, 1.57079632679489655800, a); r = __builtin_fma(-q, 6.12323399573676603587e-17, r);
    const double r2 = r * r;
    const double sp = r + r * r2 * (-1.0 / 6 + r2 * (1.0 / 120 + r2 * (-1.0 / 5040 + r2 * (1.0 / 362880 + r2 * (-1.0 / 39916800 + r2 * (1.0 / 6227020800.0))))));
    const double cp = 1.0 + r2 * (-0.5 + r2 * (1.0 / 24 + r2 * (-1.0 / 720 + r2 * (1.0 / 40320 + r2 * (-1.0 / 3628800 + r2 * (1.0 / 479001600.0 + r2 * (-1.0 / 87178291200.0)))))));
    const int n = (int)q & 3;
    const double c = (n == 0) ? cp : (n == 1) ? -sp : (n == 2) ? -cp : sp;
    const double s = (n == 0) ? sp : (n == 1) ? cp : (n == 2) ? -sp : -cp;
    CS[(size_t)p * 128 + i] = (float)c; CS[(size_t)p * 128 + 64 + i] = (float)s;
}
DI void p0_prologue(Frame& F) {
    LAS float* scr = (LAS float*)(F.lds + F.wave * 16384);
    const int gw = F.bid * NWAVES + F.wave, NGW = F.G * NWAVES;
    bf16_t* WT = (bf16_t*)(F.ws + WS_WT); bf16_t* WOT = (bf16_t*)(F.ws + WS_WOT); bf16_t* XN = (bf16_t*)(F.ws + WS_XN);
    constexpr int I_IN = (DM / 64) * (DINP / 32), I_OUT = (DM / 64) * (DM / 32);
    for (int it = gw; it < I_IN + I_OUT; it += NGW) {
        if (it < I_IN) p0_transpose_item(F.w_in, DM, DIN, WT, scr, it, DINP / 32, F.lane, [](int n) { return cmap_in(n); });
        else p0_transpose_item(F.w_out, DM, DM, WOT, scr, it - I_IN, DM / 32, F.lane, [](int n) { return n; });
    }
    for (int m = gw; m < MP; m += NGW) rms_row<false>(F.x + (size_t)m * DM, F.norm_g, XN + (size_t)m * DM, F.lane);
    if (F.bid == F.G - 1) rms_row<true>(F.xs + (size_t)F.wave * DM, F.norm_g, (float*)(F.ws + WS_XNS) + (size_t)F.wave * DM, F.lane);
    { const int gt = F.bid * NTHR + F.tid; float* CS = (float*)(F.ws + WS_CS);
      for (int idx = gt; idx < (SEQ + 1) * 64; idx += F.G * NTHR) rope_entry(CS, idx); }
}

DI void p1_sample_gemv(Frame& F) {
    LAS float* xs = (LAS float*)F.lds;
    const float* XNS = (const float*)(F.ws + WS_XNS);
    for (int i = F.tid; i < DB * DM / 4; i += NTHR) ((LAS f32x4*)xs)[i] = ((const f32x4*)XNS)[i];
    __syncthreads();
    const bf16_t* WT = (const bf16_t*)(F.ws + WS_WT); float* ZS = (float*)(F.ws + WS_ZS);
    const int gw = F.bid * NWAVES + F.wave, NGW = F.G * NWAVES, lane = F.lane;
    for (int n = gw; n < DIN; n += NGW) {
        asm volatile("" ::: "memory");
        const u32x4* wrow = (const u32x4*)(WT + (size_t)n * DM);
        float acc[8];
#pragma unroll
        for (int j = 0; j < 8; ++j) acc[j] = 0.f;
#pragma unroll
        for (int i = 0; i < 4; ++i) {
            const u32x4 w = wrow[lane + 64 * i];
            const float w0 = bflo(w.x), w1 = bfhi(w.x), w2 = bflo(w.y), w3 = bfhi(w.y), w4 = bflo(w.z), w5 = bfhi(w.z), w6 = bflo(w.w), w7 = bfhi(w.w);
#pragma unroll
            for (int j = 0; j < 8; ++j) {
                const LAS f32x4* xp = (const LAS f32x4*)(xs + j * DM + 8 * (lane + 64 * i));
                const f32x4 a = xp[0], b = xp[1];
                acc[j] += (a[0] * w0 + a[1] * w1) + (a[2] * w2 + a[3] * w3) + (b[0] * w4 + b[1] * w5) + (b[2] * w6 + b[3] * w7);
            }
        }
#pragma unroll
        for (int j = 0; j < 8; ++j) acc[j] = wave_sum(acc[j]);
        float r = acc[0];
#pragma unroll
        for (int j = 1; j < 8; ++j) r = (lane == j) ? acc[j] : r;
        if (lane < 8) ZS[(size_t)lane * DIN + cmap_in(n)] = r;
    }
    __syncthreads();
}

typedef LAS unsigned* lds_u32p;
DI void lds_inc(lds_u32p p) { (void)__hip_atomic_fetch_add(p, 1u, __ATOMIC_RELAXED, __HIP_MEMORY_SCOPE_WORKGROUP); }
DI void wave_radix_pass(const unsigned (&u)[32], lds_u32p H, int lane, unsigned mmask, unsigned mval, int shift, int need, int& bin, int& cabove, int& cbin) {
#pragma unroll
    for (int i = 0; i < 8; ++i) *(LAS u32x4*)(H + 4 * (lane + 64 * i)) = (u32x4){0u, 0u, 0u, 0u};
    asm volatile("s_waitcnt lgkmcnt(0)" ::: "memory");
#pragma unroll
    for (int i = 0; i < 32; ++i) if (u[i] != 0u && (u[i] & mmask) == mval) lds_inc(H + ((u[i] >> shift) & 2047u));
    asm volatile("s_waitcnt lgkmcnt(0)" ::: "memory");
    unsigned h[32];
#pragma unroll
    for (int i = 0; i < 8; ++i) { const u32x4 v = *(const LAS u32x4*)(H + 32 * lane + 4 * i); h[4 * i] = v.x; h[4 * i + 1] = v.y; h[4 * i + 2] = v.z; h[4 * i + 3] = v.w; }
    int s = 0;
#pragma unroll
    for (int i = 0; i < 32; ++i) s += (int)h[i];
    int x = s;
#pragma unroll
    for (int o = 1; o < 64; o <<= 1) { const int y = __shfl_down(x, o); x += (lane + o < 64) ? y : 0; }
    const int sex = x - s;
    const bool cross = (sex < need) && (sex + s >= need);
    int c = sex, bl = 0, ca = 0, cb = 0; bool found = false;
#pragma unroll
    for (int b = 31; b >= 0; --b) { const bool hit = !found && (c + (int)h[b] >= need); bl = hit ? b : bl; ca = hit ? c : ca; cb = hit ? (int)h[b] : cb; found = found || hit; c += (int)h[b]; }
    const unsigned long long m = __ballot(cross);
    const int L = (m != 0ull) ? (int)__builtin_ctzll(m) : 0;
    bin = __builtin_amdgcn_readlane(32 * lane + bl, L); cabove = __builtin_amdgcn_readlane(ca, L); cbin = __builtin_amdgcn_readlane(cb, L);
}
DI void p2_indexer_unit(Frame& F, int b, int j8, int mode = 7) {
    LAS char* L = (LAS char*)F.lds;
    LAS char* KB0 = L;
    LAS char* KB1 = L + 32768;
    LAS float* SC = (LAS float*)(L + 65536);
    const int tid = F.tid, lane = F.lane, w = F.wave, wm = w & 3, wn = w >> 2, hh = lane >> 5;
    const int t0 = 8 * j8, R0 = b * SEQ + t0, NT = ((t0 + 7) >> 7) + 1;
    const bf16_t* QI = (const bf16_t*)(F.ws + WS_QI); const bf16_t* KI = (const bf16_t*)(F.ws + WS_KI); const float* WI = (const float*)(F.ws + WS_WI);
    load_tile<128, false>(KB1, (const char*)(QI + (size_t)R0 * 2048), 256, tid);
    load_tile<128, false>(KB0, (const char*)(KI + (size_t)b * SEQ * 128), 256, tid);
    __syncthreads();
    bf16x8 qf[8];
#pragma unroll
    for (int s = 0; s < 8; ++s) qf[s] = row_frag(KB1, 32 * wm, lane, s);
    float wv[16];
#pragma unroll
    for (int r = 0; r < 16; ++r) wv[r] = WI[(size_t)(R0 + 2 * wm + (r >> 3)) * 16 + (r & 3) + 8 * ((r >> 2) & 1) + 4 * hh];
    __syncthreads();
    u32x4 kreg[4];
    for (int T = 0; T < ((mode & 1) ? NT : 0); ++T) {
        LAS char* KB = (T & 1) ? KB1 : KB0;
        if (T + 1 < NT) tile_fetch<128>(kreg, (const char*)(KI + ((size_t)b * SEQ + 128 * (T + 1)) * 128), 256, tid);
#pragma unroll
        for (int nb = 0; nb < 2; ++nb) {
            f32x16 acc = zero16();
#pragma unroll
            for (int s = 0; s < 8; ++s) acc = MFMA32(qf[s], row_frag(KB, 64 * wn + 32 * nb, lane, s), acc);
            float p0 = 0.f, p1 = 0.f;
#pragma unroll
            for (int r = 0; r < 8; ++r) { p0 += wv[r] * fmaxf(acc[r], 0.f); p1 += wv[8 + r] * fmaxf(acc[8 + r], 0.f); }
            const auto rr = __builtin_amdgcn_permlane32_swap(__float_as_uint(p0), __float_as_uint(p1), false, false);
            const int key = 128 * T + 64 * wn + 32 * nb + (lane & 31);
            SC[(2 * wm + hh) * 2048 + key] = __uint_as_float(rr[0]) + __uint_as_float(rr[1]);
        }
        if (T + 1 < NT) tile_put<128, false>((T & 1) ? KB0 : KB1, kreg, tid);
        __syncthreads();
    }
    if (!(mode & 2)) { __syncthreads(); return; }
    const int t = t0 + w; unsigned u[32];
#pragma unroll
    for (int i = 0; i < 32; ++i) { const int k = 64 * i + lane; u[i] = (k <= t) ? fkey(SC[w * 2048 + k]) : 0u; }
    unsigned long long* MASK = (unsigned long long*)(F.ws + WS_MASK) + (size_t)(R0 + w) * 32;
    const bool all = (t + 1 <= TOPK);
    unsigned T_sel = 0u, idx_cut = 0xffffffffu; bool tie = false;
    if (!all) {
        lds_u32p H = (lds_u32p)(L + w * 8192);
        int bin, ca, cb, need = TOPK;
        wave_radix_pass(u, H, lane, 0u, 0u, 21, need, bin, ca, cb);
        unsigned pre = (unsigned)bin << 21; need -= ca;
        if (need == cb) { T_sel = pre; }
        else {
            wave_radix_pass(u, H, lane, 0xffe00000u, pre, 10, need, bin, ca, cb);
            pre |= (unsigned)bin << 10; need -= ca;
            if (need == cb) { T_sel = pre; }
            else {
                wave_radix_pass(u, H, lane, 0xfffffc00u, pre, 0, need, bin, ca, cb);
                pre |= (unsigned)bin; need -= ca; T_sel = pre;
                if (need != cb) {
                    tie = true; unsigned lo = 0u, hi = 2047u;
                    while (lo < hi) { const unsigned mid = (lo + hi) >> 1; int c = 0;
#pragma unroll
                        for (int i = 0; i < 32; ++i) c += __popcll(__ballot(u[i] == pre && (unsigned)(64 * i + lane) <= mid));
                        if (c >= need) hi = mid; else lo = mid + 1u; }
                    idx_cut = lo;
                }
            }
        }
    }
#pragma unroll
    for (int i = 0; i < 32; ++i) {
        const unsigned k = 64 * i + lane; bool sel;
        if (all) sel = (int)k <= t;
        else if (!tie) sel = u[i] >= T_sel;
        else sel = (u[i] > T_sel) || (u[i] == T_sel && k <= idx_cut);
        const unsigned long long m = __ballot(sel);
        if (lane == 0 && (mode & 4)) MASK[i] = m;
    }
    __syncthreads();
}

DI void p2_retA_unit(Frame& F, int bh, int c) {
    LAS char* L = (LAS char*)F.lds; LAS char* KIMG = L; LAS char* VIMG = L + 32768;
    const int b = bh >> 3, h = bh & 7, R0 = b * SEQ + c * CH, lane = F.lane, w = F.wave, dt = w >> 1, eh = w & 1, hh = lane >> 5;
    const bf16_t* KR = (const bf16_t*)(F.ws + WS_KR); const bf16_t* VR = (const bf16_t*)(F.ws + WS_VR);
    load_tile<128, false>(KIMG, (const char*)(KR + (size_t)R0 * 1024 + h * 128), 2048, F.tid);
    load_tile<128, false>(VIMG, (const char*)(VR + (size_t)R0 * 1024 + h * 128), 2048, F.tid);
    __syncthreads();
    f32x16 acc[2] = {zero16(), zero16()};
#pragma unroll
    for (int ks = 0; ks < 8; ++ks) {
        const bf16x8 a = tr_frag(KIMG, 16 * ks, 32 * dt, lane);
#pragma unroll
        for (int e2 = 0; e2 < 2; ++e2) acc[e2] = MFMA32(a, tr_frag(VIMG, 16 * ks, 32 * (2 * eh + e2), lane), acc[e2]);
    }
    float* KV = (float*)(F.ws + WS_KV) + ((size_t)bh * NCH + c) * 16384;
#pragma unroll
    for (int e2 = 0; e2 < 2; ++e2)
#pragma unroll
        for (int r = 0; r < 16; ++r) KV[(32 * dt + crow(r, hh)) * 128 + 32 * (2 * eh + e2) + (lane & 31)] = acc[e2][r];
    __syncthreads();
}

DI void p2_sample_scores(Frame& F) {
    const int g = F.bid, b = g >> 5, lane = F.lane, key16 = lane & 15, gq = lane >> 4;
    const float* ZS = (const float*)(F.ws + WS_ZS) + (size_t)b * DIN;
    f32x4 qa[8];
#pragma unroll
    for (int t = 0; t < 8; ++t) qa[t] = *(const f32x4*)(ZS + C_QI + key16 * 128 + 16 * t + 4 * gq);
    float wv[4];
#pragma unroll
    for (int r = 0; r < 4; ++r) wv[r] = ZS[C_WI + 4 * gq + r] * WI_SCALE;
    float* SCS = (float*)(F.ws + WS_SCS) + (size_t)b * PAST;
    for (int grp = 0; grp < 4; ++grp) {
        const int s0 = 512 * (g & 31) + 64 * F.wave + 16 * grp, s = s0 + key16;
        const int page = F.ptab[b * NPAGES + (s >> 7)];
        const float* krow = F.cache_ki + ((size_t)page * PAGE + (s & 127)) * DIDX;
        f32x4 kb[8];
#pragma unroll
        for (int t = 0; t < 8; ++t) kb[t] = *(const f32x4*)(krow + 16 * t + 4 * gq);
        f32x4 acc = {0.f, 0.f, 0.f, 0.f};
#pragma unroll
        for (int t = 0; t < 8; ++t)
#pragma unroll
            for (int i = 0; i < 4; ++i) acc = __builtin_amdgcn_mfma_f32_16x16x4f32(qa[t][i], kb[t][i], acc, 0, 0, 0);
        float p = 0.f;
#pragma unroll
        for (int r = 0; r < 4; ++r) p += wv[r] * fmaxf(acc[r], 0.f);
        p += __shfl_xor(p, 16); p += __shfl_xor(p, 32);
        if (gq == 0) SCS[s] = p;
    }
}

DI void p2_sample_retention(Frame& F, int b, int h) {
    LAS float* LQ = (LAS float*)F.lds;
    LAS float* LK = LQ + 128; LAS float* LP = LQ + 256; LAS float* LO = LQ + 768;
    const float* ZS = (const float*)(F.ws + WS_ZS) + (size_t)b * DIN; const float* CS = (const float*)(F.ws + WS_CS) + (size_t)SEQ * 128;
    const int tid = F.tid;
    if (tid < 64) {
        const float c = CS[tid], s = CS[64 + tid];
        const float q1 = ZS[C_QR + h * 128 + tid], q2 = ZS[C_QR + h * 128 + 64 + tid], k1 = ZS[C_KR + h * 128 + tid], k2 = ZS[C_KR + h * 128 + 64 + tid];
        LQ[tid] = q1 * c - q2 * s; LQ[64 + tid] = q1 * s + q2 * c;
        LK[tid] = (k1 * c - k2 * s) * KSCALE; LK[64 + tid] = (k1 * s + k2 * c) * KSCALE;
    }
    __syncthreads();
    const int e = tid & 127, dq = tid >> 7; const float gam = 1.0f - __builtin_amdgcn_exp2f((float)(-5 - h));
    const float v = ZS[C_VR + h * 128 + e];
    const float* S = F.state + ((size_t)(b * NRH + h)) * 16384; float* SN = F.out + O_STS + ((size_t)(b * NRH + h)) * 16384;
    float part = 0.f;
#pragma unroll 8
    for (int dd = 0; dd < 32; ++dd) { const int d = 32 * dq + dd; const float sv = S[d * 128 + e]; part += LQ[d] * sv; SN[d * 128 + e] = gam * sv + LK[d] * v; }
    LP[dq * 128 + e] = part;
    __syncthreads();
    if (tid < 128) {
        float qk = 0.f;
#pragma unroll 8
        for (int d = 0; d < 128; ++d) qk += LQ[d] * LK[d];
        LO[tid] = qk * v + gam * ((LP[tid] + LP[128 + tid]) + (LP[256 + tid] + LP[384 + tid]));
    }
    __syncthreads();
    if (F.wave == 0) {
        const float o0 = LO[F.lane], o1 = LO[64 + F.lane];
        const float mu = wave_sum(o0 + o1) * (1.f / 128); const float d0 = o0 - mu, d1 = o1 - mu;
        const float rs = 1.0f / sqrtf(wave_sum(d0 * d0 + d1 * d1) * (1.f / 128) + EPS);
        float* ACTS = (float*)(F.ws + WS_ACTS) + (size_t)b * DM + h * 128;
        ACTS[F.lane] = d0 * rs * F.ret_g[h * 128 + F.lane] * silu(ZS[C_GR + h * 128 + F.lane]);
        ACTS[64 + F.lane] = d1 * rs * F.ret_g[h * 128 + 64 + F.lane] * silu(ZS[C_GR + h * 128 + 64 + F.lane]);
    }
    __syncthreads();
}

DI void p3_scan(Frame& F) {
    const int gt = F.bid * NTHR + F.tid;
    if (gt >= 32 * 4096) return;
    const int bh = gt >> 12, e4 = (gt & 4095) * 4, h = bh & 7;
    const float g128 = __builtin_amdgcn_exp2f(128.f * l2g(h));
    const float* KV = (const float*)(F.ws + WS_KV) + (size_t)bh * NCH * 16384 + e4; bf16_t* SP = (bf16_t*)(F.ws + WS_SP) + (size_t)bh * NCH * 16384 + e4;
    f32x4 S = {0.f, 0.f, 0.f, 0.f};
#pragma unroll 4
    for (int c = 0; c < NCH; ++c) {
        S = (S + *(const f32x4*)(KV + (size_t)c * 16384)) * g128;
        if (c + 1 < NCH) *(u32x2*)(SP + (size_t)(c + 1) * 16384) = (u32x2){cvtpk(S[0], S[1]), cvtpk(S[2], S[3])};
    }
    *(f32x4*)(F.out + O_ST + (size_t)bh * 16384 + e4) = S;
}

DI void wg_radix_pass(const unsigned (&u)[33], lds_u32p H, lds_u32p LW, int tid, int lane, int w, unsigned mmask, unsigned mval, int shift, int need, int& bin, int& cabove, int& cbin) {
    *(LAS u32x4*)(H + 4 * tid) = (u32x4){0u, 0u, 0u, 0u};
    __syncthreads();
#pragma unroll
    for (int i = 0; i < 33; ++i) if (u[i] != 0u && (u[i] & mmask) == mval) lds_inc(H + ((u[i] >> shift) & 2047u));
    __syncthreads();
    const u32x4 h = *(const LAS u32x4*)(H + 4 * tid);
    const int hv[4] = {(int)h.x, (int)h.y, (int)h.z, (int)h.w};
    const int s = (hv[0] + hv[1]) + (hv[2] + hv[3]);
    int x = s;
#pragma unroll
    for (int o = 1; o < 64; o <<= 1) { const int y = __shfl_down(x, o); x += (lane + o < 64) ? y : 0; }
    if (lane == 0) LW[w] = (unsigned)x;
    __syncthreads();
    int above = 0;
#pragma unroll
    for (int i = 0; i < 8; ++i) above += (i > w) ? (int)LW[i] : 0;
    const int sex = (x - s) + above;
    if ((sex < need) && (sex + s >= need)) {
        int c = sex, bl = 0, ca = 0, cb = 0; bool found = false;
#pragma unroll
        for (int b = 3; b >= 0; --b) { const bool hit = !found && (c + hv[b] >= need); bl = hit ? b : bl; ca = hit ? c : ca; cb = hit ? hv[b] : cb; found = found || hit; c += hv[b]; }
        LW[8] = (unsigned)(4 * tid + bl); LW[9] = (unsigned)ca; LW[10] = (unsigned)cb;
    }
    __syncthreads();
    bin = (int)LW[8]; cabove = (int)LW[9]; cbin = (int)LW[10];
    __syncthreads();
}
DI int wg_count(LAS unsigned* LU, int w, int lane, int c) {
    if (lane == 0) LU[w] = (unsigned)c;
    __syncthreads();
    int tot = 0;
#pragma unroll
    for (int i = 0; i < 8; ++i) tot += (int)LU[i];
    __syncthreads();
    return tot;
}
DI void p3_sample_attend(Frame& F, int b) {
    LAS unsigned* LU = (LAS unsigned*)F.lds;
    LAS int* LIST = (LAS int*)(F.lds + 256);
    LAS int* LROW = (LAS int*)(F.lds + 1280);
    LAS float* LG = (LAS float*)(F.lds + 4096);
    LAS float* LQA = (LAS float*)(F.lds + 12288);
    LAS float* LRED = (LAS float*)(F.lds + 16384);
    const int tid = F.tid, lane = F.lane, w = F.wave;
    const float* ZS = (const float*)(F.ws + WS_ZS) + (size_t)b * DIN; const float* SCS = (const float*)(F.ws + WS_SCS) + (size_t)b * PAST;
    for (int i = tid; i < 1024; i += NTHR) LQA[i] = ZS[C_QA + i];
    if (w == 0) {
        const int hh = lane >> 2, qd = lane & 3; float p = 0.f;
#pragma unroll 8
        for (int d = 0; d < 32; ++d) p += ZS[C_QI + hh * 128 + 32 * qd + d] * ZS[C_KI + 32 * qd + d];
        p += __shfl_xor(p, 1); p += __shfl_xor(p, 2);
        float sc = ZS[C_WI + hh] * WI_SCALE * fmaxf(p, 0.f);
        sc += __shfl_xor(sc, 4); sc += __shfl_xor(sc, 8); sc += __shfl_xor(sc, 16); sc += __shfl_xor(sc, 32);
        if (lane == 0) LU[16] = fkey(sc);
    }
    __syncthreads();
    unsigned u[33];
#pragma unroll
    for (int i = 0; i < 32; ++i) u[i] = fkey(SCS[tid + 512 * i]);
    u[32] = (tid == 0) ? LU[16] : 0u;
    lds_u32p H = (lds_u32p)(F.lds + 65536);
    unsigned prefix = 0u, idx_cut = 0xffffffffu; bool exact = true;
    {
        int bin, ca, cb, need = TOPK;
        wg_radix_pass(u, H, LU, tid, lane, w, 0u, 0u, 21, need, bin, ca, cb);
        prefix = (unsigned)bin << 21; need -= ca;
        if (need != cb) {
            wg_radix_pass(u, H, LU, tid, lane, w, 0xffe00000u, prefix, 10, need, bin, ca, cb);
            prefix |= (unsigned)bin << 10; need -= ca;
            if (need != cb) {
                wg_radix_pass(u, H, LU, tid, lane, w, 0xfffffc00u, prefix, 0, need, bin, ca, cb);
                prefix |= (unsigned)bin; need -= ca;
                if (need != cb) {
                    exact = false; unsigned lo = 0u, hi = (unsigned)PAST;
                    while (lo < hi) {
                        const unsigned mid = (lo + hi) >> 1; int cc = 0;
#pragma unroll
                        for (int i = 0; i < 33; ++i) cc += __popcll(__ballot(u[i] == prefix && (unsigned)(tid + 512 * i) <= mid));
                        if (wg_count(LU, w, lane, cc) >= need) hi = mid; else lo = mid + 1u;
                    }
                    idx_cut = lo;
                }
            }
        }
    }
    int mycnt = 0;
#pragma unroll
    for (int i = 0; i < 33; ++i) { const bool sel = exact ? (u[i] >= prefix && u[i] != 0u) : ((u[i] > prefix) || (u[i] == prefix && (unsigned)(tid + 512 * i) <= idx_cut)); mycnt += __popcll(__ballot(sel)); }
    if (lane == 0) LU[w] = (unsigned)mycnt;
    __syncthreads();
    int base = 0;
#pragma unroll
    for (int i = 0; i < 8; ++i) base += (i < w) ? (int)LU[i] : 0;
#pragma unroll
    for (int i = 0; i < 33; ++i) {
        const bool sel = exact ? (u[i] >= prefix && u[i] != 0u) : ((u[i] > prefix) || (u[i] == prefix && (unsigned)(tid + 512 * i) <= idx_cut));
        const unsigned long long m = __ballot(sel);
        if (sel) { const int pos = base + __popcll(m & ((1ull << lane) - 1ull)); if (pos < TOPK) LIST[pos] = tid + 512 * i; }
        base += __popcll(m);
    }
    __syncthreads();
    if (tid < TOPK) { const int idx = LIST[tid]; int rb = -1; if (idx < PAST) { const int page = F.ptab[b * NPAGES + (idx >> 7)]; rb = (page * PAGE + (idx & 127)) * (NKV * HD); } LROW[tid] = rb; }
    __syncthreads();
    {
        const int kk = tid >> 1, c = tid & 1, rb = LROW[kk];
        const float* krow = (rb >= 0) ? (F.cache_k + (size_t)rb + c * HD) : (ZS + C_KA + c * HD);
        float a0 = 0.f, a1 = 0.f, a2 = 0.f, a3 = 0.f;
        const LAS float* q = LQA + (4 * c) * 128;
#pragma unroll 16
        for (int d4 = 0; d4 < 32; ++d4) {
            const f32x4 kv = *(const f32x4*)(krow + 4 * d4);
            const f32x4 q0 = *(const LAS f32x4*)(q + 4 * d4), q1 = *(const LAS f32x4*)(q + 128 + 4 * d4), q2 = *(const LAS f32x4*)(q + 256 + 4 * d4), q3 = *(const LAS f32x4*)(q + 384 + 4 * d4);
            a0 += (kv[0] * q0[0] + kv[1] * q0[1]) + (kv[2] * q0[2] + kv[3] * q0[3]);
            a1 += (kv[0] * q1[0] + kv[1] * q1[1]) + (kv[2] * q1[2] + kv[3] * q1[3]);
            a2 += (kv[0] * q2[0] + kv[1] * q2[1]) + (kv[2] * q2[2] + kv[3] * q2[3]);
            a3 += (kv[0] * q3[0] + kv[1] * q3[1]) + (kv[2] * q3[2] + kv[3] * q3[3]);
        }
        LG[(4 * c + 0) * 256 + kk] = a0 * KSCALE; LG[(4 * c + 1) * 256 + kk] = a1 * KSCALE; LG[(4 * c + 2) * 256 + kk] = a2 * KSCALE; LG[(4 * c + 3) * 256 + kk] = a3 * KSCALE;
    }
    __syncthreads();
    {
        float l[4]; float mx = -3.0e38f;
#pragma unroll
        for (int i = 0; i < 4; ++i) { l[i] = LG[w * 256 + lane + 64 * i]; mx = fmaxf(mx, l[i]); }
#pragma unroll
        for (int o = 1; o < 64; o <<= 1) mx = fmaxf(mx, __shfl_xor(mx, o));
        float sum = 0.f;
#pragma unroll
        for (int i = 0; i < 4; ++i) { l[i] = __expf(l[i] - mx); sum += l[i]; }
        sum = wave_sum(sum); const float inv = 1.0f / sum;
#pragma unroll
        for (int i = 0; i < 4; ++i) LG[w * 256 + lane + 64 * i] = l[i] * inv;
    }
    __syncthreads();
    {
        const int c = tid >> 8, kg = (tid >> 5) & 7, d4 = tid & 31;
        f32x4 o[4];
#pragma unroll
        for (int h4 = 0; h4 < 4; ++h4) o[h4] = (f32x4){0.f, 0.f, 0.f, 0.f};
#pragma unroll 8
        for (int i = 0; i < 32; ++i) {
            const int kk = kg + 8 * i, rb = LROW[kk];
            const float* vrow = (rb >= 0) ? (F.cache_v + (size_t)rb + c * HD) : (ZS + C_VA + c * HD);
            const f32x4 vv = *(const f32x4*)(vrow + 4 * d4);
#pragma unroll
            for (int h4 = 0; h4 < 4; ++h4) o[h4] = o[h4] + vv * LG[(4 * c + h4) * 256 + kk];
        }
#pragma unroll
        for (int h4 = 0; h4 < 4; ++h4) *(LAS f32x4*)(LRED + (kg * 8 + 4 * c + h4) * 128 + 4 * d4) = o[h4];
    }
    __syncthreads();
    {
        float* ACTS = (float*)(F.ws + WS_ACTS) + (size_t)b * DM + 1024;
#pragma unroll
        for (int r = 0; r < 2; ++r) {
            const int e = tid + 512 * r; float s = 0.f;
#pragma unroll
            for (int kg = 0; kg < 8; ++kg) s += LRED[kg * 1024 + e];
            ACTS[e] = s * silu(ZS[C_GA + e]);
        }
    }
    __syncthreads();
}

DI void p4_attn_unit(Frame& F, int b, int j16, int mode = 7) {
    LAS char* L = (LAS char*)F.lds;
    const int tid = F.tid, lane = F.lane, w = F.wave, c = w >> 2, q16 = lane & 15, g = lane >> 4;
    const int t0 = 16 * j16, R0 = b * SEQ + t0, NT = (t0 >> 6) + 1;
    const bf16_t* QA = (const bf16_t*)(F.ws + WS_QA); const bf16_t* KA = (const bf16_t*)(F.ws + WS_KA); const bf16_t* VA = (const bf16_t*)(F.ws + WS_VA);
    const unsigned long long* MASK = (const unsigned long long*)(F.ws + WS_MASK) + (size_t)(R0 + q16) * 32;
    bf16x8 qf[4];
#pragma unroll
    for (int s = 0; s < 4; ++s) qf[s] = *(const bf16x8*)(QA + (size_t)(R0 + q16) * 1024 + w * 128 + 32 * s + 8 * g);
    f32x4 ot[8];
#pragma unroll
    for (int i = 0; i < 8; ++i) ot[i] = (f32x4){0.f, 0.f, 0.f, 0.f};
    float mrun = -1.0e30f, lrun = 0.f;
    u32x4 kr[4], vr[4];
#define ATT_FETCH(T_) do { const char* kg = (const char*)(KA + ((size_t)b * SEQ + 64 * (T_)) * 256); const char* vg = (const char*)(VA + ((size_t)b * SEQ + 64 * (T_)) * 256); \
        _Pragma("unroll") for (int i = 0; i < 4; ++i) { const int n = tid + 512 * i, row = n >> 5, cc = (n >> 4) & 1, ch = n & 15; \
            kr[i] = *(const u32x4*)(kg + (size_t)row * 512 + cc * 256 + ch * 16); vr[i] = *(const u32x4*)(vg + (size_t)row * 512 + cc * 256 + ch * 16); } } while (0)
#define ATT_PUT(buf_) do { _Pragma("unroll") for (int i = 0; i < 4; ++i) { const int n = tid + 512 * i, row = n >> 5, cc = (n >> 4) & 1, ch = n & 15; \
            *(LAS u32x4*)(L + (buf_) * 65536 + cc * 16384 + tile_off(row, ch)) = kr[i]; *(LAS u32x4*)(L + (buf_) * 65536 + 32768 + cc * 16384 + vtile_off(row, ch)) = vr[i]; } } while (0)
    ATT_FETCH(0); ATT_PUT(0);
    __syncthreads();
    for (int T = 0; T < NT; ++T) {
        LAS char* KIMG = L + (T & 1) * 65536; LAS char* VIMG = KIMG + 32768;
        if ((mode & 1) && T + 1 < NT) ATT_FETCH(T + 1);
        if (mode & 2) {
        const unsigned long long mw = MASK[T] >> (4 * g);
        const unsigned mlo = (unsigned)mw, mhi = (unsigned)(mw >> 32);
        f32x4 st[4];
#pragma unroll
        for (int kb = 0; kb < 4; ++kb) {
            st[kb] = (f32x4){0.f, 0.f, 0.f, 0.f};
#pragma unroll
            for (int s = 0; s < 4; ++s) st[kb] = MFMA16(row_frag16(KIMG + c * 16384, 16 * kb, lane, s), qf[s], st[kb]);
        }
        float mt = -1.0e30f;
#pragma unroll
        for (int kb = 0; kb < 4; ++kb)
#pragma unroll
            for (int r = 0; r < 4; ++r) { const unsigned bit = ((kb < 2 ? mlo : mhi) >> (16 * (kb & 1) + r)) & 1u; st[kb][r] = bit ? st[kb][r] : -1.0e30f; mt = fmaxf(mt, st[kb][r]); }
        mt = fmaxf(mt, __shfl_xor(mt, 16)); mt = fmaxf(mt, __shfl_xor(mt, 32));
        const float mnew = fmaxf(mrun, mt), alpha = __builtin_amdgcn_exp2f(mrun - mnew);
        mrun = mnew; lrun *= alpha;
#pragma unroll
        for (int i = 0; i < 8; ++i) ot[i] = ot[i] * alpha;
        float ps = 0.f;
#pragma unroll
        for (int kb = 0; kb < 4; ++kb)
#pragma unroll
            for (int r = 0; r < 4; ++r) { const float p = (st[kb][r] > -0.5e30f) ? __builtin_amdgcn_exp2f(st[kb][r] - mnew) : 0.f; st[kb][r] = p; ps += p; }
        lrun += ps;
#pragma unroll
        for (int ks = 0; ks < 2; ++ks) {
            const u32x4 pw = {cvtpk(st[2 * ks][0], st[2 * ks][1]), cvtpk(st[2 * ks][2], st[2 * ks][3]), cvtpk(st[2 * ks + 1][0], st[2 * ks + 1][1]), cvtpk(st[2 * ks + 1][2], st[2 * ks + 1][3])};
            const bf16x8 pb = __builtin_bit_cast(bf16x8, pw);
#pragma unroll
            for (int c8 = 0; c8 < 8; ++c8) ot[c8] = MFMA16(tr16_perm(VIMG + c * 16384, 32 * ks, c8, lane), pb, ot[c8]);
        }
        }
        if ((mode & 1) && T + 1 < NT) ATT_PUT((T + 1) & 1);
        __syncthreads();
    }
#undef ATT_FETCH
#undef ATT_PUT
    lrun += __shfl_xor(lrun, 16); lrun += __shfl_xor(lrun, 32);
    if (!(mode & 4)) return;
    const float inv = 1.0f / lrun;
    const bf16_t* GA = (const bf16_t*)(F.ws + WS_GA) + (size_t)(R0 + q16) * 1024 + w * 128; bf16_t* ACT = (bf16_t*)(F.ws + WS_ACT) + (size_t)(R0 + q16) * DM + 1024 + w * 128;
#pragma unroll
    for (int c8 = 0; c8 < 8; ++c8) {
        const int d = 16 * c8 + 4 * g; const u32x2 gw = *(const u32x2*)(GA + d);
        const float o0 = ot[c8][0] * inv * bflo(gw.x), o1 = ot[c8][1] * inv * bfhi(gw.x), o2 = ot[c8][2] * inv * bflo(gw.y), o3 = ot[c8][3] * inv * bfhi(gw.y);
        *(u32x2*)(ACT + d) = (u32x2){cvtpk(o0, o1), cvtpk(o2, o3)};
    }
}

DI void p4_attn_pair(Frame& F, int b, int jj, int mode = 7) {
    LAS char* L = (LAS char*)F.lds;
    const int tid = F.tid, lane = F.lane, w = F.wave, set = w >> 2, hp = w & 3, c = hp >> 1, r32 = lane & 31, hh = lane >> 5, q = r32 & 15, head = 2 * hp + (r32 >> 4);
    const int t0 = set ? 16 * (127 - jj) : 16 * jj, R0 = b * SEQ + t0, NTA = ((16 * jj) >> 6) + 1, NTB = ((16 * (127 - jj)) >> 6) + 1, NTme = set ? NTB : NTA;
    const bf16_t* QA = (const bf16_t*)(F.ws + WS_QA); const bf16_t* KA = (const bf16_t*)(F.ws + WS_KA); const bf16_t* VA = (const bf16_t*)(F.ws + WS_VA);
    const unsigned long long* MASK = (const unsigned long long*)(F.ws + WS_MASK) + (size_t)(R0 + q) * 32;
    bf16x8 qf[8];
#pragma unroll
    for (int s = 0; s < 8; ++s) qf[s] = *(const bf16x8*)(QA + (size_t)(R0 + q) * 1024 + head * 128 + 16 * s + 8 * hh);
    f32x16 ot[4] = {zero16(), zero16(), zero16(), zero16()};
    float mrun = -1.0e30f, lrun = 0.f;
    u32x4 kr[4], vr[4];
#define ATT_FETCH(T_) do { const char* kg = (const char*)(KA + ((size_t)b * SEQ + 64 * (T_)) * 256); const char* vg = (const char*)(VA + ((size_t)b * SEQ + 64 * (T_)) * 256); \
        _Pragma("unroll") for (int i = 0; i < 4; ++i) { const int n = tid + 512 * i, row = n >> 5, cc = (n >> 4) & 1, ch = n & 15; \
            kr[i] = *(const u32x4*)(kg + (size_t)row * 512 + cc * 256 + ch * 16); vr[i] = *(const u32x4*)(vg + (size_t)row * 512 + cc * 256 + ch * 16); } } while (0)
#define ATT_PUT(buf_) do { _Pragma("unroll") for (int i = 0; i < 4; ++i) { const int n = tid + 512 * i, row = n >> 5, cc = (n >> 4) & 1, ch = n & 15; \
            *(LAS u32x4*)(L + (buf_) * 65536 + cc * 16384 + tile_off(row, ch)) = kr[i]; *(LAS u32x4*)(L + (buf_) * 65536 + 32768 + cc * 16384 + tile_off(row, ch)) = vr[i]; } } while (0)
    ATT_FETCH(0); ATT_PUT(0);
    __syncthreads();
    for (int T = 0; T < NTB; ++T) {
        const LAS char* KIMG = L + (T & 1) * 65536 + c * 16384; const LAS char* VIMG = L + (T & 1) * 65536 + 32768 + c * 16384;
        if ((mode & 1) && T + 1 < NTB) ATT_FETCH(T + 1);
        if ((mode & 2) && T < NTme) {
            const unsigned long long mw = MASK[T] >> (4 * hh);
            const unsigned mlo = (unsigned)mw, mhi = (unsigned)(mw >> 32);
            f32x16 st[2];
#pragma unroll
            for (int kb = 0; kb < 2; ++kb) {
                st[kb] = zero16();
#pragma unroll
                for (int s = 0; s < 8; ++s) st[kb] = MFMA32(row_frag(KIMG, 32 * kb, lane, s), qf[s], st[kb]);
                asm volatile("" ::: "memory");
            }
            float mt = fmaxf(st[0][0], st[1][0]);
#pragma unroll
            for (int r = 1; r < 16; ++r) mt = fmaxf(mt, fmaxf(st[0][r], st[1][r]));
            { const auto rr = __builtin_amdgcn_permlane32_swap(__float_as_uint(mt), __float_as_uint(mt), false, false); mt = fmaxf(__uint_as_float(rr[0]), __uint_as_float(rr[1])); }
            if (__any(mt > mrun + 8.0f)) {
                const float mnew = fmaxf(mrun, mt), alpha = __builtin_amdgcn_exp2f(mrun - mnew);
                mrun = mnew; lrun *= alpha;
#pragma unroll
                for (int i = 0; i < 4; ++i) ot[i] = ot[i] * alpha;
            }
            float ps = 0.f;
#pragma unroll
            for (int kb = 0; kb < 2; ++kb)
#pragma unroll
                for (int r = 0; r < 16; ++r) {
                    const unsigned bit = ((kb ? mhi : mlo) >> ((r & 3) + 8 * (r >> 2))) & 1u;
                    const float p = bit ? __builtin_amdgcn_exp2f(st[kb][r] - mrun) : 0.f; st[kb][r] = p; ps += p;
                }
            lrun += ps;
#pragma unroll
            for (int s2 = 0; s2 < 4; ++s2) {
                const int kb = s2 >> 1, o8 = 8 * (s2 & 1);
                const u32x4 pw = {cvtpk(st[kb][o8 + 0], st[kb][o8 + 1]), cvtpk(st[kb][o8 + 2], st[kb][o8 + 3]), cvtpk(st[kb][o8 + 4], st[kb][o8 + 5]), cvtpk(st[kb][o8 + 6], st[kb][o8 + 7])};
                const bf16x8 pb = __builtin_bit_cast(bf16x8, pw);
#pragma unroll
                for (int db = 0; db < 4; ++db) ot[db] = MFMA32(tr_frag_perm(VIMG, 16 * s2, 32 * db, lane), pb, ot[db]);
                asm volatile("" ::: "memory");
            }
        }
        if ((mode & 1) && T + 1 < NTB) ATT_PUT((T + 1) & 1);
        __syncthreads();
    }
#undef ATT_FETCH
#undef ATT_PUT
    if (!(mode & 4)) return;
    { const auto rr = __builtin_amdgcn_permlane32_swap(__float_as_uint(lrun), __float_as_uint(lrun), false, false); lrun = __uint_as_float(rr[0]) + __uint_as_float(rr[1]); }
    const float inv = 1.0f / lrun;
    const bf16_t* GA = (const bf16_t*)(F.ws + WS_GA) + (size_t)(R0 + q) * 1024 + head * 128; bf16_t* ACT = (bf16_t*)(F.ws + WS_ACT) + (size_t)(R0 + q) * DM + 1024 + head * 128;
#pragma unroll
    for (int db = 0; db < 4; ++db)
#pragma unroll
        for (int r4 = 0; r4 < 4; ++r4) {
            const int d = 32 * db + 8 * r4 + 4 * hh; const u32x2 gw = *(const u32x2*)(GA + d);
            const float o0 = ot[db][4 * r4 + 0] * inv * bflo(gw.x), o1 = ot[db][4 * r4 + 1] * inv * bfhi(gw.x), o2 = ot[db][4 * r4 + 2] * inv * bflo(gw.y), o3 = ot[db][4 * r4 + 3] * inv * bfhi(gw.y);
            *(u32x2*)(ACT + d) = (u32x2){cvtpk(o0, o1), cvtpk(o2, o3)};
        }
}

DI void p4_attn_unit32(Frame& F, int b, int c, int j32, int mode = 7) {
    LAS char* L = (LAS char*)F.lds;
    const int tid = F.tid, lane = F.lane, w = F.wave, h4 = w & 3, kh = w >> 2, r32 = lane & 31, hh = lane >> 5, head = 4 * c + h4;
    const int t0 = 32 * j32, R0 = b * SEQ + t0, NT = (j32 >> 1) + 1;
    const bf16_t* QA = (const bf16_t*)(F.ws + WS_QA); const bf16_t* KA = (const bf16_t*)(F.ws + WS_KA); const bf16_t* VA = (const bf16_t*)(F.ws + WS_VA);
    const unsigned long long* MASK = (const unsigned long long*)(F.ws + WS_MASK) + (size_t)(R0 + r32) * 32;
    bf16x8 qf[8];
#pragma unroll
    for (int s = 0; s < 8; ++s) qf[s] = *(const bf16x8*)(QA + (size_t)(R0 + r32) * 1024 + head * 128 + 16 * s + 8 * hh);
    f32x16 ot[4] = {zero16(), zero16(), zero16(), zero16()};
    float mrun = -1.0e30f, lrun = 0.f;
    u32x4 kr[2], vr[2];
#define ATT_FETCH(T_) do { const char* kg = (const char*)(KA + ((size_t)b * SEQ + 64 * (T_)) * 256 + c * 128); const char* vg = (const char*)(VA + ((size_t)b * SEQ + 64 * (T_)) * 256 + c * 128); \
        _Pragma("unroll") for (int i = 0; i < 2; ++i) { const int n = tid + 512 * i, row = n >> 4, ch = n & 15; \
            kr[i] = *(const u32x4*)(kg + (size_t)row * 512 + ch * 16); vr[i] = *(const u32x4*)(vg + (size_t)row * 512 + ch * 16); } } while (0)
#define ATT_PUT(buf_) do { _Pragma("unroll") for (int i = 0; i < 2; ++i) { const int n = tid + 512 * i, row = n >> 4, ch = n & 15; \
            *(LAS u32x4*)(L + (buf_) * 32768 + tile_off(row, ch)) = kr[i]; *(LAS u32x4*)(L + (buf_) * 32768 + 16384 + tile_off(row, ch)) = vr[i]; } } while (0)
    __syncthreads();
    ATT_FETCH(0); ATT_PUT(0);
    __syncthreads();
    for (int T = 0; T < NT; ++T) {
        const LAS char* KIMG = L + (T & 1) * 32768; const LAS char* VIMG = KIMG + 16384;
        if ((mode & 1) && T + 1 < NT) ATT_FETCH(T + 1);
        if (mode & 2) {
            const unsigned long long mw = MASK[T] >> (4 * hh);
            const unsigned mbits = kh ? (unsigned)(mw >> 32) : (unsigned)mw;
            f32x16 st = zero16();
#pragma unroll
            for (int s = 0; s < 8; ++s) st = MFMA32(row_frag(KIMG, 32 * kh, lane, s), qf[s], st);
            float mt = st[0];
#pragma unroll
            for (int r = 1; r < 16; ++r) mt = fmaxf(mt, st[r]);
            { const auto rr = __builtin_amdgcn_permlane32_swap(__float_as_uint(mt), __float_as_uint(mt), false, false); mt = fmaxf(__uint_as_float(rr[0]), __uint_as_float(rr[1])); }
            if (__any(mt > mrun + 8.0f)) {
                const float mnew = fmaxf(mrun, mt), alpha = __builtin_amdgcn_exp2f(mrun - mnew);
                mrun = mnew; lrun *= alpha;
#pragma unroll
                for (int i = 0; i < 4; ++i) ot[i] = ot[i] * alpha;
            }
            float ps = 0.f;
#pragma unroll
            for (int r = 0; r < 16; ++r) {
                const unsigned bit = (mbits >> ((r & 3) + 8 * (r >> 2))) & 1u;
                const float p = bit ? __builtin_amdgcn_exp2f(st[r] - mrun) : 0.f; st[r] = p; ps += p;
            }
            lrun += ps;
#pragma unroll
            for (int s2 = 0; s2 < 2; ++s2) {
                const int o8 = 8 * s2;
                const u32x4 pw = {cvtpk(st[o8 + 0], st[o8 + 1]), cvtpk(st[o8 + 2], st[o8 + 3]), cvtpk(st[o8 + 4], st[o8 + 5]), cvtpk(st[o8 + 6], st[o8 + 7])};
                const bf16x8 pb = __builtin_bit_cast(bf16x8, pw);
#pragma unroll
                for (int db = 0; db < 4; ++db) ot[db] = MFMA32(tr_frag_perm(VIMG, 32 * kh + 16 * s2, 32 * db, lane), pb, ot[db]);
            }
        }
        if ((mode & 1) && T + 1 < NT) ATT_PUT((T + 1) & 1);
        __syncthreads();
    }
#undef ATT_FETCH
#undef ATT_PUT
    LAS float* MB = (LAS float*)L + h4 * 4224;
    if (kh == 1) {
#pragma unroll
        for (int db = 0; db < 4; ++db)
#pragma unroll
            for (int r = 0; r < 16; ++r) MB[(16 * db + r) * 64 + lane] = ot[db][r];
        MB[4096 + lane] = mrun; MB[4160 + lane] = lrun;
    }
    __syncthreads();
    if (kh == 0 && (mode & 4)) {
        const float m1 = MB[4096 + lane], l1 = MB[4160 + lane];
        const float m = fmaxf(mrun, m1), a0 = __builtin_amdgcn_exp2f(mrun - m), a1 = __builtin_amdgcn_exp2f(m1 - m);
        float l = lrun * a0 + l1 * a1;
        { const auto rr = __builtin_amdgcn_permlane32_swap(__float_as_uint(l), __float_as_uint(l), false, false); l = __uint_as_float(rr[0]) + __uint_as_float(rr[1]); }
        const float inv = 1.0f / l;
        const bf16_t* GA = (const bf16_t*)(F.ws + WS_GA) + (size_t)(R0 + r32) * 1024 + head * 128; bf16_t* ACT = (bf16_t*)(F.ws + WS_ACT) + (size_t)(R0 + r32) * DM + 1024 + head * 128;
#pragma unroll
        for (int db = 0; db < 4; ++db)
#pragma unroll
            for (int r4 = 0; r4 < 4; ++r4) {
                const int d = 32 * db + 8 * r4 + 4 * hh; const u32x2 gw = *(const u32x2*)(GA + d);
                float o[4];
#pragma unroll
                for (int e = 0; e < 4; ++e) o[e] = (ot[db][4 * r4 + e] * a0 + MB[(16 * db + 4 * r4 + e) * 64 + lane] * a1) * inv;
                *(u32x2*)(ACT + d) = (u32x2){cvtpk(o[0] * bflo(gw.x), o[1] * bfhi(gw.x)), cvtpk(o[2] * bflo(gw.y), o[3] * bfhi(gw.y))};
            }
    }
    __syncthreads();
}

DI void p4_retB_unit(Frame& F, int bh, int c) {
    LAS char* L = (LAS char*)F.lds; LAS char* QIMG = L; LAS char* KIMG = L + 32768; LAS char* VIMG = L + 65536; LAS char* SIMG = L + 98304;
    LAS float* OUT = (LAS float*)L;
    const int b = bh >> 3, h = bh & 7, R0 = b * SEQ + c * CH, tid = F.tid, lane = F.lane, w = F.wave, it = w >> 1, eh = w & 1, hh = lane >> 5;
    const bf16_t* QR = (const bf16_t*)(F.ws + WS_QR); const bf16_t* KR = (const bf16_t*)(F.ws + WS_KR); const bf16_t* VR = (const bf16_t*)(F.ws + WS_VR);
    __syncthreads();
    load_tile<128, false>(QIMG, (const char*)(QR + (size_t)R0 * 1024 + h * 128), 2048, tid);
    load_tile<128, false>(KIMG, (const char*)(KR + (size_t)R0 * 1024 + h * 128), 2048, tid);
    load_tile<128, false>(VIMG, (const char*)(VR + (size_t)R0 * 1024 + h * 128), 2048, tid);
    if (c > 0) load_tile<128, false>(SIMG, (const char*)((const bf16_t*)(F.ws + WS_SP) + ((size_t)bh * NCH + c) * 16384), 256, tid);
    __syncthreads();
    f32x16 acc[2] = {zero16(), zero16()};
    bf16x8 qf[8];
#pragma unroll
    for (int s = 0; s < 8; ++s) qf[s] = row_frag(QIMG, 32 * it, lane, s);
    if (c > 0) {
#pragma unroll
        for (int s = 0; s < 8; ++s)
#pragma unroll
            for (int e2 = 0; e2 < 2; ++e2) acc[e2] = MFMA32(qf[s], tr_frag(SIMG, 16 * s, 32 * (2 * eh + e2), lane), acc[e2]);
    }
    for (int jt = 0; jt <= it; ++jt) {
        f32x16 X = zero16();
#pragma unroll
        for (int s = 0; s < 8; ++s) X = MFMA32(row_frag(KIMG, 32 * jt, lane, s), qf[s], X);
        if (jt == it) {
#pragma unroll
            for (int r = 0; r < 16; ++r) X[r] = (crow(r, hh) > (lane & 31)) ? 0.f : X[r];
        }
#pragma unroll
        for (int s2 = 0; s2 < 2; ++s2) {
            const u32x4 pw = {cvtpk(X[8 * s2 + 0], X[8 * s2 + 1]), cvtpk(X[8 * s2 + 2], X[8 * s2 + 3]), cvtpk(X[8 * s2 + 4], X[8 * s2 + 5]), cvtpk(X[8 * s2 + 6], X[8 * s2 + 7])};
            const bf16x8 xs = __builtin_bit_cast(bf16x8, pw);
#pragma unroll
            for (int e2 = 0; e2 < 2; ++e2) acc[e2] = MFMA32(xs, tr_frag_perm(VIMG, 32 * jt + 16 * s2, 32 * (2 * eh + e2), lane), acc[e2]);
        }
    }
    __syncthreads();
#pragma unroll
    for (int e2 = 0; e2 < 2; ++e2)
#pragma unroll
        for (int r = 0; r < 16; ++r) OUT[(32 * it + crow(r, hh)) * 129 + 32 * (2 * eh + e2) + (lane & 31)] = acc[e2][r];
    __syncthreads();
    {
        const int i = tid >> 2, qd = tid & 3; float v[32]; float s = 0.f;
#pragma unroll
        for (int e = 0; e < 32; ++e) { v[e] = OUT[i * 129 + 32 * qd + e]; s += v[e]; }
        s += __shfl_xor(s, 1); s += __shfl_xor(s, 2);
        const float mu = s * (1.f / 128); float q = 0.f;
#pragma unroll
        for (int e = 0; e < 32; ++e) { v[e] -= mu; q += v[e] * v[e]; }
        q += __shfl_xor(q, 1); q += __shfl_xor(q, 2);
        const float rs = 1.0f / sqrtf(q * (1.f / 128) + EPS);
        const bf16_t* GR = (const bf16_t*)(F.ws + WS_GR) + (size_t)(R0 + i) * 1024 + h * 128 + 32 * qd; bf16_t* ACT = (bf16_t*)(F.ws + WS_ACT) + (size_t)(R0 + i) * DM + h * 128 + 32 * qd;
        const float* rg = F.ret_g + h * 128 + 32 * qd;
#pragma unroll
        for (int e8 = 0; e8 < 4; ++e8) {
            const u32x4 gw = *(const u32x4*)(GR + 8 * e8); const f32x4 g0 = *(const f32x4*)(rg + 8 * e8), g1 = *(const f32x4*)(rg + 8 * e8 + 4);
            const float o0 = v[8 * e8 + 0] * rs * g0[0] * bflo(gw.x), o1 = v[8 * e8 + 1] * rs * g0[1] * bfhi(gw.x), o2 = v[8 * e8 + 2] * rs * g0[2] * bflo(gw.y), o3 = v[8 * e8 + 3] * rs * g0[3] * bfhi(gw.y);
            const float o4 = v[8 * e8 + 4] * rs * g1[0] * bflo(gw.z), o5 = v[8 * e8 + 5] * rs * g1[1] * bfhi(gw.z), o6 = v[8 * e8 + 6] * rs * g1[2] * bflo(gw.w), o7 = v[8 * e8 + 7] * rs * g1[3] * bfhi(gw.w);
            *(u32x4*)(ACT + 8 * e8) = (u32x4){cvtpk(o0, o1), cvtpk(o2, o3), cvtpk(o4, o5), cvtpk(o6, o7)};
        }
    }
    __syncthreads();
}

DI void p5_sample_outproj(Frame& F) {
    LAS float* xs = (LAS float*)F.lds;
    const float* ACTS = (const float*)(F.ws + WS_ACTS);
    for (int i = F.tid; i < DB * DM / 4; i += NTHR) ((LAS f32x4*)xs)[i] = ((const f32x4*)ACTS)[i];
    __syncthreads();
    const bf16_t* WOT = (const bf16_t*)(F.ws + WS_WOT);
    const int gw = F.bid * NWAVES + F.wave, NGW = F.G * NWAVES, lane = F.lane;
    for (int n = gw; n < DM; n += NGW) {
        asm volatile("" ::: "memory");
        const u32x4* wrow = (const u32x4*)(WOT + (size_t)n * DM);
        float acc[8];
#pragma unroll
        for (int j = 0; j < 8; ++j) acc[j] = 0.f;
#pragma unroll
        for (int i = 0; i < 4; ++i) {
            const u32x4 w = wrow[lane + 64 * i];
            const float w0 = bflo(w.x), w1 = bfhi(w.x), w2 = bflo(w.y), w3 = bfhi(w.y), w4 = bflo(w.z), w5 = bfhi(w.z), w6 = bflo(w.w), w7 = bfhi(w.w);
#pragma unroll
            for (int j = 0; j < 8; ++j) {
                const LAS f32x4* xp = (const LAS f32x4*)(xs + j * DM + 8 * (lane + 64 * i));
                const f32x4 a = xp[0], b = xp[1];
                acc[j] += (a[0] * w0 + a[1] * w1) + (a[2] * w2 + a[3] * w3) + (b[0] * w4 + b[1] * w5) + (b[2] * w6 + b[3] * w7);
            }
        }
#pragma unroll
        for (int j = 0; j < 8; ++j) acc[j] = wave_sum(acc[j]);
        float r = acc[0];
#pragma unroll
        for (int j = 1; j < 8; ++j) r = (lane == j) ? acc[j] : r;
        if (lane < 8) ((float*)(F.ws + WS_HPS))[(size_t)lane * DM + n] = F.xs[(size_t)lane * DM + n] + r;
    }
    __syncthreads();
}

DI void p6_final_norm(Frame& F) {
    const int gw = F.bid * NWAVES + F.wave, NGW = F.G * NWAVES, lane = F.lane;
    const float* PART = (const float*)(F.ws + WS_PART);
    for (int m = gw; m < MP; m += NGW) {
        float ss = (lane < 32) ? PART[(size_t)m * 32 + lane] : 0.f;
        ss = wave_sum(ss);
        const float rstd = 1.0f / sqrtf(ss * (1.f / DM) + EPS);
        f32x4* y = (f32x4*)(F.out + O_Y + (size_t)m * DM); const f32x4* hp = (const f32x4*)((const float*)(F.ws + WS_HP) + (size_t)m * DM); f32x4 v[8];
#pragma unroll
        for (int j = 0; j < 8; ++j) v[j] = hp[lane + 64 * j];
#pragma unroll
        for (int j = 0; j < 8; ++j) { const f32x4 gv = ((const f32x4*)F.fin_g)[lane + 64 * j]; y[lane + 64 * j] = v[j] * rstd * gv; }
    }
    if (F.bid == F.G - 1) rms_row<true>((const float*)(F.ws + WS_HPS) + (size_t)F.wave * DM, F.fin_g, F.out + O_YS + (size_t)F.wave * DM, lane);
}

constexpr int NPHASE = 7;
struct Args { const void* in[12]; float* out; unsigned char* ws; int ph_lo, ph_hi, sub, pad; };
__global__ void __launch_bounds__(NTHR, 2) hymba_fwd(Args args) {
    extern __shared__ __attribute__((aligned(16))) unsigned char lds_raw[];
    Frame F;
    F.lds = (LAS unsigned char*)lds_raw; F.MISC = (volatile LAS unsigned*)(F.lds + MISC_OFF);
    F.tid = threadIdx.x; F.lane = F.tid & 63; F.wave = __builtin_amdgcn_readfirstlane(F.tid >> 6); F.G = gridDim.x; F.bid = blockIdx.x;
    F.x = (const float*)args.in[0]; F.xs = (const float*)args.in[1]; F.cache_k = (const float*)args.in[2]; F.cache_v = (const float*)args.in[3]; F.cache_ki = (const float*)args.in[4];
    F.state = (const float*)args.in[5]; F.ptab = (const int*)args.in[6]; F.norm_g = (const float*)args.in[7]; F.w_in = (const float*)args.in[8]; F.ret_g = (const float*)args.in[9];
    F.w_out = (const float*)args.in[10]; F.fin_g = (const float*)args.in[11]; F.out = args.out; F.ws = args.ws; F.ctl = (unsigned*)(args.ws + WS_CTL);
    for (int u = F.tid; u < (LDS_BYTES - RING_BYTES) / 4; u += NTHR) ((LAS unsigned*)(F.lds + RING_BYTES))[u] = 0u;
    __syncthreads();
    const int lo = args.ph_lo, hi = args.ph_hi;
    const bool use_bar = (hi - lo) > 1;
    XcdBarrier bar; bar.bar = F.ctl + CW_BAR; bar.x = 0; bar.st = nullptr;
    if (use_bar) bar = xcd_barrier_post(F.ctl + CW_BAR, F.MISC + 8);
#ifndef PHASE_MASK
#define PHASE_MASK 0x7f
#endif
#define IN(k) (((PHASE_MASK >> (k)) & 1) && lo <= (k) && (k) < hi)
#define SEAM(k) do { if (IN(k) && IN((k) + 1)) xcd_barrier(bar); } while (0)
    const int g = F.bid;
    if (IN(0)) { p0_prologue(F); SEAM(0); }
    if (IN(1)) {
        p1_sample_gemv(F);
        pg8::Gemm gm{(const bf16_t*)(F.ws + WS_XN), (const bf16_t*)(F.ws + WS_WT), MP, DINP, DM}; pg8::StaticOrder S; S.init(MP, DINP, F.G, g);
        EpiInProj E{(bf16_t*)(F.ws + WS_QR), (bf16_t*)(F.ws + WS_KR), (bf16_t*)(F.ws + WS_VR), (bf16_t*)(F.ws + WS_GR), (bf16_t*)(F.ws + WS_QA), (bf16_t*)(F.ws + WS_KA), (bf16_t*)(F.ws + WS_VA),
                    (bf16_t*)(F.ws + WS_GA), (bf16_t*)(F.ws + WS_QI), (bf16_t*)(F.ws + WS_KI), (float*)(F.ws + WS_WI), F.out + O_NK, F.out + O_NV, F.out + O_NKI, (const float*)(F.ws + WS_CS)};
        pg8::gemm_phase<EpiInProj, pg8::StaticOrder, true, true>(F.lds, gm, S, E);
        SEAM(1);
    }
    if (IN(2)) {
        if (g == 64) { const float* ZS = (const float*)(F.ws + WS_ZS);
            for (int i = F.tid; i < DB * 256; i += NTHR) { const int b = i >> 8, k = i & 255; F.out[O_NKS + i] = ZS[(size_t)b * DIN + C_KA + k]; F.out[O_NVS + i] = ZS[(size_t)b * DIN + C_VA + k]; }
            for (int i = F.tid; i < DB * 128; i += NTHR) { const int b = i >> 7, k = i & 127; F.out[O_NKIS + i] = ZS[(size_t)b * DIN + C_KI + k]; } }
        const int sub = args.sub;
        if (sub & 1) p2_sample_scores(F);
        if ((sub & 2) && g < 64) p2_sample_retention(F, g >> 3, g & 7);
        __syncthreads();
        if (sub & 4) for (int u = g; u < 512; u += F.G) p2_retA_unit(F, u >> 4, u & 15);
        if (sub & 56) for (int bq = 0; bq < NB; ++bq) { const int j = (bq & 1) ? (255 - (g & 255)) : (g & 255); if (g < 256) p2_indexer_unit(F, bq, j, (sub & 8) ? 7 : ((sub & 16) ? 1 : 2)); }
        SEAM(2);
    }
    if (IN(3)) {
        if ((args.sub & 1) && g < DB) p3_sample_attend(F, g);
        if (args.sub & 2) p3_scan(F);
        SEAM(3);
    }
    if (IN(4)) {
        if (args.sub & 1) for (int u = g; u < 512; u += F.G) p4_retB_unit(F, u >> 4, u & 15);
        if ((args.sub & 14) && g < 256) { const int b = g >> 6, c2 = (g >> 5) & 1, jj = g & 31; const int md = (args.sub & 2) ? 7 : ((args.sub & 4) ? 1 : 2); p4_attn_unit32(F, b, c2, jj, md); p4_attn_unit32(F, b, c2, 63 - jj, md); }
        SEAM(4);
    }
    if (IN(5)) {
        p5_sample_outproj(F);
        pg8::Gemm gm{(const bf16_t*)(F.ws + WS_ACT), (const bf16_t*)(F.ws + WS_WOT), MP, DM, DM}; pg8::StaticOrder S; S.init(MP, DM, F.G, g);
        EpiOutProj E{F.x, (float*)(F.ws + WS_HP), (float*)(F.ws + WS_PART)};
        pg8::gemm_phase<EpiOutProj, pg8::StaticOrder, false, true>(F.lds, gm, S, E);
        SEAM(5);
    }
    if (IN(6)) p6_final_norm(F);
#undef IN
#undef SEAM
}

extern "C" void kernel_launch(void* const* d_in, const int* in_sizes, int n_in, void* d_out, int out_size, void* d_ws, size_t ws_size, hipStream_t stream) {
    static int grid = 0;
    if (grid == 0) {
        if (n_in != 12 || ws_size < WS_END) { fprintf(stderr, "kernel_launch: unexpected inputs (n_in %d, ws %zu)\n", n_in, ws_size); grid = -1; return; }
        if (hipFuncSetAttribute((const void*)hymba_fwd, hipFuncAttributeMaxDynamicSharedMemorySize, LDS_BYTES) != hipSuccess) { fprintf(stderr, "kernel_launch: hipFuncSetAttribute failed\n"); grid = -1; return; }
        int dev = 0, cus = 0, per_cu = 0;
        hipGetDevice(&dev); hipDeviceGetAttribute(&cus, hipDeviceAttributeMultiprocessorCount, dev);
        hipOccupancyMaxActiveBlocksPerMultiprocessor(&per_cu, (const void*)hymba_fwd, NTHR, LDS_BYTES);
        (void)hipGetLastError();
        if (per_cu < 1) fprintf(stderr, "kernel_launch: occupancy query reports %d blocks per CU\n", per_cu);
        grid = 256;
        if (cus < 256) fprintf(stderr, "kernel_launch: device has %d CUs; this kernel needs 256 co-resident workgroups\n", cus);
    }
    if (grid < 0) return;
    (void)hipMemsetAsync((char*)d_ws + WS_CTL, 0, CTL_ZERO_BYTES, stream);
    Args a{};
    for (int i = 0; i < 12; ++i) a.in[i] = d_in[i];
    a.out = (float*)d_out; a.ws = (unsigned char*)d_ws; a.sub = 0xff;
    if (MK_N_LAUNCHES == 1) {
        a.ph_lo = 0; a.ph_hi = NPHASE;
        hipLaunchKernelGGL(hymba_fwd, dim3(grid), dim3(NTHR), LDS_BYTES, stream, a);
    } else {
        for (int p = 0; p < NPHASE; ++p) {
            int reps = 1;
#ifdef PROBE_DOUBLE
            if (p == PROBE_DOUBLE) reps = 2;
#endif
            for (int r = 0; r < reps; ++r) { a.ph_lo = p; a.ph_hi = p + 1; a.sub = 0xff;
#ifdef PROBE_SUB
                if (r == 1) a.sub = PROBE_SUB;
#endif
                hipLaunchKernelGGL(hymba_fwd, dim3(grid), dim3(NTHR), LDS_BYTES, stream, a); }
        }
    }
}
```

```cpp
#include <hip/hip_runtime.h>
#include <cstdint>
#include <cstdio>

#define DI __device__ __forceinline__
#define LAS __attribute__((address_space(3)))
#define GAS __attribute__((address_space(1)))
typedef unsigned short bf16_t;
typedef short bf16x8 __attribute__((ext_vector_type(8)));
typedef short s16x4 __attribute__((ext_vector_type(4)));
typedef float f32x2 __attribute__((ext_vector_type(2)));
typedef float f32x4 __attribute__((ext_vector_type(4)));
typedef float f32x16 __attribute__((ext_vector_type(16)));
typedef unsigned u32x2 __attribute__((ext_vector_type(2)));
typedef unsigned u32x4 __attribute__((ext_vector_type(4)));
typedef __bf16 bf16x2_t __attribute__((ext_vector_type(2)));

#ifndef MK_N_LAUNCHES
#define MK_N_LAUNCHES 1
#endif

constexpr int DM = 2048, NB = 4, SEQ = 2048, MP = NB * SEQ  , DB = 8  , PAST = 16384, PAGE = 128, NPAGES = PAST / PAGE;
constexpr int HD = 128, NRH = 8, NAH = 8, NKV = 2, DKV = 256, NIH = 16, DIDX = 128, TOPK = 256, CH = 128  , NCH = SEQ / CH;
constexpr int DIN = 8848, DINP = 8960;
constexpr int C_QR = 0, C_KR = 1024, C_VR = 2048, C_GR = 3072, C_QA = 4096, C_KA = 5120, C_VA = 5376, C_GA = 5632, C_QI = 6656, C_KI = 8704, C_WI = 8832;
constexpr float EPS = 1e-6f;
constexpr float KSCALE = 0.08838834764831845f;
constexpr float QA_SCALE = 0.08838834764831845f * 1.4426950408889634f;
constexpr float WI_SCALE = 0.022097086912079608f;
constexpr size_t O_Y = 0, O_YS = 16777216, O_NK = 16793600, O_NV = 18890752, O_NKI = 20987904, O_ST = 22036480, O_NKS = 22560768, O_NVS = 22562816, O_NKIS = 22564864, O_STS = 22565888;
constexpr size_t MiB = 1u << 20;
constexpr size_t WS_CTL = 0, CTL_ZERO_BYTES = 1 * MiB;
constexpr size_t WS_WT = 2 * MiB;
constexpr size_t WS_WOT = 40 * MiB;
constexpr size_t WS_XN = 48 * MiB;
constexpr size_t WS_QR = 80 * MiB;
constexpr size_t WS_KR = 96 * MiB, WS_VR = 112 * MiB, WS_GR = 128 * MiB, WS_QA = 144 * MiB, WS_GA = 160 * MiB;
constexpr size_t WS_KA = 176 * MiB;
constexpr size_t WS_VA = 180 * MiB;
constexpr size_t WS_QI = 184 * MiB;
constexpr size_t WS_KI = 216 * MiB;
constexpr size_t WS_WI = 218 * MiB;
constexpr size_t WS_CS = 219 * MiB;
constexpr size_t WS_XNS = 221 * MiB;
constexpr size_t WS_ZS = 222 * MiB;
constexpr size_t WS_ACTS = 223 * MiB;
constexpr size_t WS_SCS = 224 * MiB;
constexpr size_t WS_PART = 225 * MiB;
constexpr size_t WS_MASK = 226 * MiB;
constexpr size_t WS_KV = 228 * MiB;
constexpr size_t WS_SP = 260 * MiB;
constexpr size_t WS_ACT = 276 * MiB;
constexpr size_t WS_HP = 308 * MiB;
constexpr size_t WS_HPS = 372 * MiB;
constexpr size_t WS_END = 373 * MiB;

__device__ const float ROPE_INV[64] = {
1.f, 0.865964353f, 0.749894261f, 0.649381638f, 0.562341332f, 0.486967534f, 0.421696514f, 0.365174115f, 0.316227764f, 0.273841977f, 0.237137377f, 0.2053525f, 0.177827939f, 0.153992653f, 0.133352131f, 0.115478203f,
0.100000001f, 0.0865964293f, 0.0749894157f, 0.0649381652f, 0.0562341325f, 0.0486967526f, 0.0421696529f, 0.0365174115f, 0.0316227749f, 0.0273841973f, 0.0237137377f, 0.0205352511f, 0.0177827943f, 0.0153992651f, 0.0133352149f, 0.0115478206f,
0.00999999978f, 0.00865964312f, 0.00749894185f, 0.00649381615f, 0.00562341325f, 0.00486967526f, 0.00421696482f, 0.00365174119f, 0.00316227763f, 0.00273841969f, 0.00237137359f, 0.00205352483f, 0.00177827943f, 0.00153992651f, 0.00133352145f, 0.0011547819f,
0.00100000005f, 0.000865964335f, 0.000749894243f, 0.000649381662f, 0.000562341302f, 0.000486967532f, 0.000421696517f, 0.000365174143f, 0.000316227757f, 0.000273841957f, 0.00023713737f, 0.00020535251f, 0.00017782794f, 0.000153992645f, 0.00013335215f, 0.0001154782f};
DI float l2g(int h) {
    const float t[8] = {-0.04580368961312479f, -0.02272007650008353f, -0.011315313227834146f, -0.005646563141142063f, -0.0028205190623786626f, -0.0014095702546713536f, -0.0007046129765893727f, -0.0003522634716290214f};
    float r = t[0];
#pragma unroll
    for (int i = 1; i < 8; ++i) r = (h == i) ? t[i] : r;
    return r;
}

#define LDS_WAIT() asm volatile("s_waitcnt lgkmcnt(0)" ::: "memory")
#define VM_WAIT() asm volatile("s_waitcnt vmcnt(0)" ::: "memory")
DI unsigned cvtpk(float lo, float hi) { f32x2 v = {lo, hi}; bf16x2_t b = __builtin_convertvector(v, bf16x2_t); return __builtin_bit_cast(unsigned, b); }
DI float bf2f(unsigned short b) { return __uint_as_float((unsigned)b << 16); }
DI float bflo(unsigned w) { return __uint_as_float(w << 16); }
DI float bfhi(unsigned w) { return __uint_as_float(w & 0xffff0000u); }
DI float wave_sum(float v) {
#pragma unroll
    for (int o = 1; o < 64; o <<= 1) v += __shfl_xor(v, o);
    return v;
}
DI float silu(float x) { return x / (1.f + __expf(-x)); }
DI unsigned fkey(float s) { const unsigned b = __float_as_uint(s); return (b & 0x80000000u) ? ~b : (b | 0x80000000u); }

namespace pg8 {
constexpr int BM = 256, BK = 64, HALF = 128, HTB = HALF * BK * 2, STAGE_BYTES = 8 * HTB, NXCD = 8, WGM = 8;
DI int lds_byte(int r, int c) { const int st = (r >> 4) * 2 + (c >> 5), rr = r & 15, cc = c & 31, ob = rr * 64 + cc * 2; return st * 1024 + (ob ^ (((ob >> 9) & 1) << 5)); }
DI void stage_rc(int b, int& R, int& C) { const int st = b / 1024, sb = b % 1024, swz = sb ^ (((sb >> 9) & 1) << 5); R = (st >> 1) * 16 + swz / 64; C = (st & 1) * 32 + (swz % 64) / 2; }
DI int perm32(int rho) { const int n = rho >> 4, i = rho & 15; return 8 * (i >> 2) + 4 * n + (i & 3); }
struct Unit { int pm, pn; };
struct Gemm { const bf16_t* A; const bf16_t* Bt; int M, N, K; };
struct StaticOrder {
    int nM, nN, nwg, G, c;
    DI void init(int M, int N, int G_, int c_) { nM = M / BM; nN = N / BM; nwg = nM * nN; G = G_; c = c_; }
    DI bool next(int i, Unit& u) const {
        const long L = (long)i * G + c; if (L >= nwg) return false;
        int wgid = (int)L; { const int q = nwg / NXCD, r = nwg % NXCD, xcd = wgid % NXCD, off = wgid / NXCD; wgid = (xcd < r ? xcd * (q + 1) : r * (q + 1) + (xcd - r) * q) + off; }
        const int nig = WGM * nN, gid = wgid / nig, fm = gid * WGM, gsz = (nM - fm) < WGM ? (nM - fm) : WGM;
        u.pm = fm + ((wgid % nig) % gsz); u.pn = (wgid % nig) / gsz; return true;
    }
    DI void a_ready(const Unit&) const {}
    DI void done(const Unit&) const {}
};

template <class Epi, class Sched, bool ALIGN_EPI = false, bool SP2 = false>
DI void gemm_phase(LAS unsigned char* lds, const Gemm g, const Sched& S, const Epi& E) {
    const int tid = threadIdx.x, wid = __builtin_amdgcn_readfirstlane(tid >> 6), lane = tid & 63, wr = wid >> 2, wc = wid & 3, fr = lane & 15, fq = lane >> 4;
    const int K = g.K, nt = K / BK;
    unsigned voffA[2], voffB[2];
#pragma unroll
    for (int i = 0; i < 2; ++i) { int R, C; stage_rc(tid * 16 + i * 8192, R, C); const int Rb = Epi::PERM ? ((R & ~31) + perm32(R & 31)) : R;
        voffA[i] = (unsigned)(R * K + C) * 2u; voffB[i] = (unsigned)(Rb * K + C) * 2u; }
    const size_t kstep = (size_t)(BK * 2);
    const size_t hstep = (size_t)HALF * K * 2;
    const size_t tstep = 2 * hstep;
    const unsigned ldsw = (unsigned)wid * 1024u;
    const int aoff = lds_byte(wr * 64 + fr, fq * 8), boff = lds_byte(wc * 32 + fr, fq * 8);
#define PG8_SA(b, h) (((b) * 2 + (h)) * HTB)
#define PG8_SB(b, h) ((4 + (b) * 2 + (h)) * HTB)
#define PG8_STAGE(bufoff, gbase, voff) do { _Pragma("unroll") for (int _i = 0; _i < 2; ++_i) \
        __builtin_amdgcn_global_load_lds((const unsigned*)((const char*)(gbase) + (voff)[_i]), (LAS unsigned*)(lds + (bufoff) + ldsw + _i * 8192), 16, 0, 0); } while (0)
#define PG8_LDA(dst, b, h) do { _Pragma("unroll") for (int m = 0; m < 4; ++m) _Pragma("unroll") for (int k = 0; k < 2; ++k) dst[m][k] = *(const LAS bf16x8*)(lds + PG8_SA(b, h) + aoff + m * 2048 + k * 1024); } while (0)
#define PG8_LDB(dst, b, h) do { _Pragma("unroll") for (int n = 0; n < 2; ++n) _Pragma("unroll") for (int k = 0; k < 2; ++k) dst[n][k] = *(const LAS bf16x8*)(lds + PG8_SB(b, h) + boff + n * 2048 + k * 1024); } while (0)
#define PG8_MMA(ai, bj, At, Bt) do { __builtin_amdgcn_s_setprio(1); _Pragma("unroll") for (int m = 0; m < 4; ++m) _Pragma("unroll") for (int n = 0; n < 2; ++n) _Pragma("unroll") for (int k = 0; k < 2; ++k) \
        acc[ai][bj][m][n] = __builtin_amdgcn_mfma_f32_16x16x32_bf16(Bt[n][k], At[m][k], acc[ai][bj][m][n], 0, 0, 0); __builtin_amdgcn_s_setprio(0); } while (0)
#define PG8_WAIT_V(n) asm volatile("s_waitcnt vmcnt(" #n ")" ::: "memory")
#define PG8_WAIT_L(n) asm volatile("s_waitcnt lgkmcnt(" #n ")" ::: "memory")
#define PG8_BAR __builtin_amdgcn_s_barrier()
#define PG8_SCHED __builtin_amdgcn_sched_barrier(0)
    Unit cur, nxt; int ui = 0;
    if (!S.next(0, cur)) return;
    f32x4 acc[2][2][4][2];
#pragma unroll
    for (int a = 0; a < 2; ++a)
#pragma unroll
        for (int b = 0; b < 2; ++b)
#pragma unroll
            for (int m = 0; m < 4; ++m)
#pragma unroll
                for (int n = 0; n < 2; ++n) acc[a][b][m][n] = (f32x4){0.f, 0.f, 0.f, 0.f};
    bf16x8 At[4][2], B0[2][2], B1[2][2];
    const char* cA = (const char*)g.A + (size_t)cur.pm * tstep; const char* cB = (const char*)g.Bt + (size_t)cur.pn * tstep;
    S.a_ready(cur);
    if constexpr (SP2) {
        PG8_STAGE(PG8_SB(0, 0), cB, voffB); PG8_STAGE(PG8_SB(0, 1), cB + hstep, voffB); PG8_STAGE(PG8_SA(0, 0), cA, voffA); PG8_STAGE(PG8_SA(0, 1), cA + hstep, voffA);
        if (wr == 1) PG8_BAR;
        PG8_WAIT_V(2); PG8_BAR;
        PG8_STAGE(PG8_SB(1, 0), cB + kstep, voffB); PG8_STAGE(PG8_SA(1, 0), cA + kstep, voffA); PG8_STAGE(PG8_SB(1, 1), cB + hstep + kstep, voffB);
        PG8_WAIT_V(6); PG8_BAR;
    } else {
        PG8_STAGE(PG8_SB(0, 0), cB, voffB); PG8_STAGE(PG8_SA(0, 0), cA, voffA); PG8_STAGE(PG8_SB(0, 1), cB + hstep, voffB); PG8_STAGE(PG8_SA(0, 1), cA + hstep, voffA);
        if (wr == 1) PG8_BAR;
        PG8_WAIT_V(4); PG8_BAR;
        PG8_STAGE(PG8_SB(1, 0), cB + kstep, voffB); PG8_STAGE(PG8_SA(1, 0), cA + kstep, voffA); PG8_STAGE(PG8_SB(1, 1), cB + hstep + kstep, voffB);
        PG8_WAIT_V(6); PG8_BAR;
    }
    for (;;) {
        const bool has_next = S.next(ui + 1, nxt);
        const char* nA = has_next ? (const char*)g.A + (size_t)nxt.pm * tstep : cA; const char* nB = has_next ? (const char*)g.Bt + (size_t)nxt.pn * tstep : cB;
        for (int t = 0; t < nt; t += 2) {
            const bool last = (t == nt - 2);
            const char* a1 = cA + (size_t)(t + 1) * kstep;
            const char* a2 = last ? nA : cA + (size_t)(t + 2) * kstep; const char* b2 = last ? nB : cB + (size_t)(t + 2) * kstep;
            const char* a3 = a2 + kstep; const char* b3 = b2 + kstep;
            if (last && has_next) S.a_ready(nxt);
            if constexpr (SP2) {
            PG8_LDB(B0, 0, 0); PG8_LDB(B1, 0, 1); PG8_SCHED; PG8_LDA(At, 0, 0); PG8_STAGE(PG8_SA(1, 1), a1 + hstep, voffA);
            PG8_WAIT_V(8); PG8_WAIT_L(0); PG8_BAR; PG8_MMA(0, 0, At, B0); PG8_MMA(0, 1, At, B1); PG8_BAR; PG8_SCHED;
            PG8_LDA(At, 0, 1); PG8_STAGE(PG8_SB(0, 0), b2, voffB); PG8_STAGE(PG8_SB(0, 1), b2 + hstep, voffB); PG8_STAGE(PG8_SA(0, 0), a2, voffA);
            PG8_WAIT_V(8); PG8_WAIT_L(0); PG8_BAR; PG8_MMA(1, 0, At, B0); PG8_MMA(1, 1, At, B1); PG8_BAR; PG8_SCHED;
            PG8_LDB(B0, 1, 0); PG8_LDB(B1, 1, 1); PG8_SCHED; PG8_LDA(At, 1, 0); PG8_STAGE(PG8_SA(0, 1), a2 + hstep, voffA);
            PG8_WAIT_V(8); PG8_WAIT_L(0); PG8_BAR; PG8_MMA(0, 0, At, B0); PG8_MMA(0, 1, At, B1); PG8_BAR; PG8_SCHED;
            PG8_LDA(At, 1, 1); PG8_STAGE(PG8_SB(1, 0), b3, voffB); PG8_STAGE(PG8_SB(1, 1), b3 + hstep, voffB); PG8_STAGE(PG8_SA(1, 0), a3, voffA);
            PG8_WAIT_V(8); PG8_WAIT_L(0); PG8_BAR; PG8_MMA(1, 0, At, B0); PG8_MMA(1, 1, At, B1); PG8_BAR; PG8_SCHED;
            } else {
            PG8_LDB(B0, 0, 0); PG8_SCHED; PG8_LDA(At, 0, 0); PG8_STAGE(PG8_SA(1, 1), a1 + hstep, voffA);
            PG8_WAIT_L(8); PG8_BAR; PG8_WAIT_L(0); PG8_MMA(0, 0, At, B0); PG8_BAR; PG8_SCHED;
            PG8_LDB(B1, 0, 1); PG8_STAGE(PG8_SB(0, 0), b2, voffB);
            PG8_BAR; PG8_WAIT_L(0); PG8_MMA(0, 1, At, B1); PG8_BAR;
            PG8_LDA(At, 0, 1); PG8_STAGE(PG8_SA(0, 0), a2, voffA);
            PG8_BAR; PG8_WAIT_L(0); PG8_MMA(1, 0, At, B0); PG8_BAR; PG8_SCHED;
            PG8_STAGE(PG8_SB(0, 1), b2 + hstep, voffB);
            PG8_WAIT_V(6); PG8_BAR; PG8_MMA(1, 1, At, B1); PG8_BAR;
            PG8_LDB(B0, 1, 0); PG8_SCHED; PG8_LDA(At, 1, 0); PG8_STAGE(PG8_SA(0, 1), a2 + hstep, voffA);
            PG8_WAIT_L(8); PG8_BAR; PG8_WAIT_L(0); PG8_MMA(0, 0, At, B0); PG8_BAR; PG8_SCHED;
            PG8_LDB(B1, 1, 1); PG8_STAGE(PG8_SB(1, 0), b3, voffB);
            PG8_BAR; PG8_WAIT_L(0); PG8_MMA(0, 1, At, B1); PG8_BAR;
            PG8_LDA(At, 1, 1); PG8_STAGE(PG8_SA(1, 0), a3, voffA);
            PG8_BAR; PG8_WAIT_L(0); PG8_MMA(1, 0, At, B0); PG8_BAR; PG8_SCHED;
            PG8_STAGE(PG8_SB(1, 1), b3 + hstep, voffB);
            PG8_WAIT_V(6); PG8_BAR; PG8_MMA(1, 1, At, B1); PG8_BAR;
            }
        }
        if constexpr (ALIGN_EPI) { if (wr == 0) PG8_BAR; }
        if constexpr (!Epi::AFTER_DRAIN) { E(acc, cur, wr, wc, fr, fq); S.done(cur); }
        if (!has_next) break;
#pragma unroll
        for (int a = 0; a < 2; ++a)
#pragma unroll
            for (int b = 0; b < 2; ++b)
#pragma unroll
                for (int m = 0; m < 4; ++m)
#pragma unroll
                    for (int n = 0; n < 2; ++n) acc[a][b][m][n] = (f32x4){0.f, 0.f, 0.f, 0.f};
        cur = nxt; cA = nA; cB = nB; ++ui;
        if constexpr (ALIGN_EPI) { if (wr == 1) PG8_BAR; }
    }
    PG8_WAIT_V(0);
    if constexpr (!ALIGN_EPI) { if (wr == 0) PG8_BAR; }
    PG8_BAR;
#undef PG8_SA
#undef PG8_SB
#undef PG8_STAGE
#undef PG8_LDA
#undef PG8_LDB
#undef PG8_MMA
#undef PG8_WAIT_V
#undef PG8_WAIT_L
#undef PG8_BAR
#undef PG8_SCHED
}
}

DI int cmap_in(int c) {
    if (c >= DIN) return -1;
    if (c >= C_VR) return c;
    const int hb = c & ~127, s = c & 127, g = s >> 3, e = s & 7;
    return hb + ((e < 4) ? (4 * g + e) : (64 + 4 * g + (e - 4)));
}

struct EpiInProj {
    static constexpr bool PERM = true, AFTER_DRAIN = false;
    bf16_t *QR, *KR, *VR, *GR, *QA, *KA, *VA, *GA, *QI, *KI; float* WI; float *oK, *oV, *oKI; const float* CS;
    DI void operator()(const f32x4 (&acc)[2][2][4][2], const pg8::Unit& u, int wr, int wc, int fr, int fq) const {
        const int pn = u.pn, rowb = u.pm * 256 + wr * 64 + fr, cl = wc * 32 + 8 * fq;
        if (pn < 8) {
            const bool isq = pn < 4; bf16_t* dst = isq ? QR : KR; const int g4 = 4 * (4 * wc + fq);
#pragma unroll
            for (int ai = 0; ai < 2; ++ai)
#pragma unroll
                for (int m = 0; m < 4; ++m) {
                    const int row = rowb + ai * 128 + m * 16, pos = row & (SEQ - 1), ic = pos & (CH - 1);
                    const f32x4 cs = *(const f32x4*)(CS + (size_t)pos * 128 + g4), sn = *(const f32x4*)(CS + (size_t)pos * 128 + 64 + g4);
#pragma unroll
                    for (int bj = 0; bj < 2; ++bj) {
                        const int head = 2 * (pn & 3) + bj;
                        const float lg = l2g(head) * (float)(ic + 1);
                        const float sc = isq ? __builtin_amdgcn_exp2f(lg) : KSCALE * __builtin_amdgcn_exp2f(-lg);
                        const f32x4 x1 = acc[ai][bj][m][0], x2 = acc[ai][bj][m][1];
                        const f32x4 o1 = (x1 * cs - x2 * sn) * sc, o2 = (x1 * sn + x2 * cs) * sc;
                        bf16_t* p = dst + (size_t)row * 1024 + head * 128 + g4;
                        *(u32x2*)p = (u32x2){cvtpk(o1[0], o1[1]), cvtpk(o1[2], o1[3])};
                        *(u32x2*)(p + 64) = (u32x2){cvtpk(o2[0], o2[1]), cvtpk(o2[2], o2[3])};
                    }
                }
            return;
        }
        int kind; bf16_t* bdst = nullptr; int ld = 0, cbase = 0; float* fdst = nullptr; int fld = 0;
        if (pn < 12) { kind = 0; bdst = VR; ld = 1024; cbase = (pn - 8) * 256; }
        else if (pn < 16) { kind = 1; bdst = GR; ld = 1024; cbase = (pn - 12) * 256; }
        else if (pn < 20) { kind = 2; bdst = QA; ld = 1024; cbase = (pn - 16) * 256; }
        else if (pn == 20) { kind = 3; bdst = KA; ld = 256; cbase = 0; fdst = oK; fld = 256; }
        else if (pn == 21) { kind = 3; bdst = VA; ld = 256; cbase = 0; fdst = oV; fld = 256; }
        else if (pn < 26) { kind = 1; bdst = GA; ld = 1024; cbase = (pn - 22) * 256; }
        else if (pn < 34) { kind = 0; bdst = QI; ld = 2048; cbase = (pn - 26) * 256; }
        else { kind = 4; }
#pragma unroll
        for (int ai = 0; ai < 2; ++ai)
#pragma unroll
            for (int m = 0; m < 4; ++m) {
                const int row = rowb + ai * 128 + m * 16;
#pragma unroll
                for (int bj = 0; bj < 2; ++bj) {
                    f32x4 v0 = acc[ai][bj][m][0], v1 = acc[ai][bj][m][1];
                    const int col = bj * 128 + cl;
                    if (kind == 4) {
                        if (bj == 0) {
                            *(f32x4*)(oKI + (size_t)row * 128 + col) = v0; *(f32x4*)(oKI + (size_t)row * 128 + col + 4) = v1;
                            *(u32x4*)(KI + (size_t)row * 128 + col) = (u32x4){cvtpk(v0[0], v0[1]), cvtpk(v0[2], v0[3]), cvtpk(v1[0], v1[1]), cvtpk(v1[2], v1[3])};
                        } else if (cl < 16) {
                            *(f32x4*)(WI + (size_t)row * 16 + cl) = v0 * WI_SCALE; *(f32x4*)(WI + (size_t)row * 16 + cl + 4) = v1 * WI_SCALE;
                        }
                        continue;
                    }
                    if (kind == 3) { *(f32x4*)(fdst + (size_t)row * fld + col) = v0; *(f32x4*)(fdst + (size_t)row * fld + col + 4) = v1; }
                    if (kind == 1) {
#pragma unroll
                        for (int e = 0; e < 4; ++e) { v0[e] = silu(v0[e]); v1[e] = silu(v1[e]); }
                    }
                    if (kind == 2) { v0 = v0 * QA_SCALE; v1 = v1 * QA_SCALE; }
                    *(u32x4*)(bdst + (size_t)row * ld + cbase + col) = (u32x4){cvtpk(v0[0], v0[1]), cvtpk(v0[2], v0[3]), cvtpk(v1[0], v1[1]), cvtpk(v1[2], v1[3])};
                }
            }
    }
};

struct EpiOutProj {
    static constexpr bool PERM = false, AFTER_DRAIN = false;
    const float* X; float* Y; float* PART;
    DI void operator()(const f32x4 (&acc)[2][2][4][2], const pg8::Unit& u, int wr, int wc, int fr, int fq) const {
        const int rowb = u.pm * 256 + wr * 64 + fr, col0 = u.pn * 256 + wc * 32 + 4 * fq;
#pragma unroll
        for (int ai = 0; ai < 2; ++ai)
#pragma unroll
            for (int m = 0; m < 4; ++m) {
                const int row = rowb + ai * 128 + m * 16; float ss = 0.f;
#pragma unroll
                for (int bj = 0; bj < 2; ++bj)
#pragma unroll
                    for (int n = 0; n < 2; ++n) {
                        const size_t off = (size_t)row * DM + col0 + bj * 128 + n * 16;
                        const f32x4 h = *(const f32x4*)(X + off) + acc[ai][bj][m][n];
                        *(f32x4*)(Y + off) = h; ss += (h[0] * h[0] + h[1] * h[1]) + (h[2] * h[2] + h[3] * h[3]);
                    }
                ss += __shfl_xor(ss, 16); ss += __shfl_xor(ss, 32);
                if (fq == 0) PART[(size_t)row * 32 + u.pn * 4 + wc] = ss;
            }
    }
};

DI unsigned tile_off(unsigned row, unsigned ch) { return 256u * row + 16u * (ch ^ (((row & 3) << 2) | ((row >> 2) & 3))); }
DI unsigned vtile_off(unsigned row, unsigned ch) { return 256u * row + 16u * (ch ^ (((row & 3) << 2) | (((row >> 2) & 1) << 1))); }
typedef short v4i16_t __attribute__((ext_vector_type(4)));
DI s16x4 tr4(const LAS char* p) { return __builtin_bit_cast(s16x4, __builtin_amdgcn_ds_read_tr16_b64_v4i16((LAS v4i16_t*)p)); }
DI bf16x8 row_frag(const LAS char* img, int row0, int lane, int s) { return *(const LAS bf16x8*)(img + tile_off(row0 + (lane & 31), 2 * s + (lane >> 5))); }
DI bf16x8 tr_frag(const LAS char* img, int krow0, int col0, int lane) {
    const unsigned h = lane >> 5, blk = (lane >> 4) & 1, q = (lane & 15) >> 2, p = lane & 3, ch = (col0 >> 3) + 2 * blk + (p >> 1);
    const s16x4 lo = tr4(img + tile_off(krow0 + 8 * h + q, ch) + 8 * (p & 1)), hi = tr4(img + tile_off(krow0 + 8 * h + 4 + q, ch) + 8 * (p & 1));
    return __builtin_shufflevector(lo, hi, 0, 1, 2, 3, 4, 5, 6, 7);
}
DI bf16x8 tr_frag_perm(const LAS char* img, int krow0, int col0, int lane) {
    const unsigned h = lane >> 5, blk = (lane >> 4) & 1, q = (lane & 15) >> 2, p = lane & 3, ch = (col0 >> 3) + 2 * blk + (p >> 1);
    const s16x4 lo = tr4(img + tile_off(krow0 + 4 * h + q, ch) + 8 * (p & 1)), hi = tr4(img + tile_off(krow0 + 8 + 4 * h + q, ch) + 8 * (p & 1));
    return __builtin_shufflevector(lo, hi, 0, 1, 2, 3, 4, 5, 6, 7);
}
DI bf16x8 row_frag16(const LAS char* img, int row0, int lane, int s) { return *(const LAS bf16x8*)(img + tile_off(row0 + (lane & 15), 4 * s + (lane >> 4))); }
DI bf16x8 tr16_perm(const LAS char* img, int krow0, int c8, int lane) {
    const unsigned g = lane >> 4, q = (lane & 15) >> 2, p = lane & 3, ch = 2 * c8 + (p >> 1);
    const s16x4 lo = tr4(img + vtile_off(krow0 + 4 * g + q, ch) + 8 * (p & 1)), hi = tr4(img + vtile_off(krow0 + 16 + 4 * g + q, ch) + 8 * (p & 1));
    return __builtin_shufflevector(lo, hi, 0, 1, 2, 3, 4, 5, 6, 7);
}
template <int NROWS, bool VT> DI void load_tile(LAS char* img, const char* g, size_t gstride, int tid) {
#pragma unroll
    for (int i = 0; i < NROWS * 16 / 512; ++i) {
        const int n = tid + 512 * i, row = n >> 4, ch = n & 15;
        const u32x4 v = *(const u32x4*)(g + (size_t)row * gstride + ch * 16);
        *(LAS u32x4*)(img + (VT ? vtile_off(row, ch) : tile_off(row, ch))) = v;
    }
}
template <int NROWS> DI void tile_fetch(u32x4 (&v)[NROWS * 16 / 512], const char* g, size_t gstride, int tid) {
#pragma unroll
    for (int i = 0; i < NROWS * 16 / 512; ++i) { const int n = tid + 512 * i, row = n >> 4, ch = n & 15; v[i] = *(const u32x4*)(g + (size_t)row * gstride + ch * 16); }
}
template <int NROWS, bool VT> DI void tile_put(LAS char* img, const u32x4 (&v)[NROWS * 16 / 512], int tid) {
#pragma unroll
    for (int i = 0; i < NROWS * 16 / 512; ++i) { const int n = tid + 512 * i, row = n >> 4, ch = n & 15; *(LAS u32x4*)(img + (VT ? vtile_off(row, ch) : tile_off(row, ch))) = v[i]; }
}
DI f32x16 zero16() { f32x16 z;
#pragma unroll
    for (int i = 0; i < 16; ++i) z[i] = 0.f;
    return z; }
DI int crow(int r, int h) { return (r & 3) + 8 * (r >> 2) + 4 * h; }
#define MFMA32(a, b, c) __builtin_amdgcn_mfma_f32_32x32x16_bf16((a), (b), (c), 0, 0, 0)
#define MFMA16(a, b, c) __builtin_amdgcn_mfma_f32_16x16x32_bf16((a), (b), (c), 0, 0, 0)

constexpr int NWAVES = 8, NTHR = 512;
constexpr int RING_BYTES = 131072, MISC_OFF = RING_BYTES + 320, LDS_BYTES = 147456;
struct Frame {
    LAS unsigned char* lds; volatile LAS unsigned* MISC; unsigned* ctl;
    int tid, lane, wave, G, bid;
    const float *x, *xs, *cache_k, *cache_v, *cache_ki, *state, *norm_g, *w_in, *ret_g, *w_out, *fin_g; const int* ptab;
    float* out; unsigned char* ws;
};

#define XB_TMO      128
#define XB_XCNT(j)  (256  + 64 * (j))
#define XB_XSUB(j)  (1280 + 64 * (j))
#define XB_XGEN(j)  (2304 + 64 * (j))
#define XB_TOP      3328
#define XB_TOPGEN   3392
#define XCD_BAR_WORDS 3456
#define XB_SPIN_CAP (1u << 20)
constexpr int CW_BAR = 4096, CW_ZS = 64;
DI unsigned xb_ld(unsigned* p) { return __hip_atomic_load(p, __ATOMIC_RELAXED, __HIP_MEMORY_SCOPE_AGENT); }
DI unsigned xb_add(unsigned* p, unsigned v) { return __hip_atomic_fetch_add(p, v, __ATOMIC_RELAXED, __HIP_MEMORY_SCOPE_AGENT); }
DI unsigned xb_xcc_id() { return (unsigned)__builtin_amdgcn_s_getreg((3 << 11) | 20) & 0xFu; }
#define XB_SPIN(cond, bar) do { unsigned _sp = 0; while (cond) { __builtin_amdgcn_s_sleep(1); \
    if ((++_sp & 255u) == 0u) { if (xb_ld(&(bar)[XB_TMO])) break; if (_sp > XB_SPIN_CAP) { atomicAdd(&(bar)[XB_TMO], 1u); break; } } } } while (0)
struct XcdBarrier { unsigned* bar; unsigned x; volatile LAS unsigned* st; };
DI XcdBarrier xcd_barrier_post(unsigned* bar, volatile LAS unsigned* st) {
    XcdBarrier b; b.bar = bar; b.x = xb_xcc_id(); b.st = st;
    if (threadIdx.x == 0) (void)xb_add(&bar[XB_XCNT(b.x)], 1u);
    return b;
}
DI void xcd_barrier_complete(unsigned* bar, unsigned x, unsigned& nloc, unsigned& nx) {
    const unsigned G = gridDim.x * gridDim.y * gridDim.z;
    unsigned sum, cnt, mine, sp = 0u;
    for (;;) {
        sum = 0u; cnt = 0u; mine = 0u;
#pragma unroll
        for (unsigned j = 0; j < 16; ++j) { const unsigned c = xb_ld(&bar[XB_XCNT(j)]); sum += c; cnt += (c > 0u) ? 1u : 0u; mine = (j == x) ? c : mine; }
        if (sum == G) break;
        __builtin_amdgcn_s_sleep(1);
        if ((++sp & 255u) == 0u) { if (xb_ld(&bar[XB_TMO])) break; if (sp > XB_SPIN_CAP) { atomicAdd(&bar[XB_TMO], 1u); break; } }
    }
    nloc = mine > 0u ? mine : 1u; nx = cnt > 0u ? cnt : 1u;
}
DI void xcd_barrier(const XcdBarrier& b) {
    asm volatile("s_waitcnt vmcnt(0)" ::: "memory");
    __syncthreads();
    if (threadIdx.x == 0) {
        unsigned* bar = b.bar;
        __builtin_amdgcn_s_waitcnt(0);
        unsigned nloc = b.st[0], nx = b.st[1];
        if (nloc == 0u) { xcd_barrier_complete(bar, b.x, nloc, nx); b.st[0] = nloc; b.st[1] = nx; }
        const unsigned old = xb_add(&bar[XB_XSUB(b.x)], 1u);
        const unsigned gen = old / nloc;
        if (old + 1u == (gen + 1u) * nloc) {
            __builtin_amdgcn_fence(__ATOMIC_RELEASE, "agent");
            asm volatile("s_waitcnt vmcnt(0)" ::: "memory");
            const unsigned og = xb_add(&bar[XB_TOP], 1u);
            const unsigned tg = og / nx;
            if (og + 1u == (tg + 1u) * nx) xb_add(&bar[XB_TOPGEN], 1u);
            else XB_SPIN(xb_ld(&bar[XB_TOPGEN]) == tg, bar);
            __builtin_amdgcn_fence(__ATOMIC_ACQUIRE, "agent");
            xb_add(&bar[XB_XGEN(b.x)], 1u);
            asm volatile("s_waitcnt vmcnt(0)" ::: "memory");
        } else {
            XB_SPIN(xb_ld(&bar[XB_XGEN(b.x)]) == gen, bar);
            __builtin_amdgcn_fence(__ATOMIC_ACQUIRE, "agent");
            asm volatile("s_waitcnt vmcnt(0)" ::: "memory");
        }
    }
    __syncthreads();
}

template <class CMap> DI void p0_transpose_item(const float* W, int K, int ldw, bf16_t* WT, LAS float* scr, int item, int nblk, int lane, CMap cm) {
    const int kb = item / nblk, nb = item % nblk, k0 = 64 * kb, n0 = 32 * nb;
    const int col = cm(n0 + (lane & 31));
#pragma unroll 8
    for (int i = 0; i < 32; ++i) { const int kk = 2 * i + (lane >> 5); scr[kk * 33 + (lane & 31)] = (col >= 0) ? W[(size_t)(k0 + kk) * ldw + col] : 0.f; }
    LDS_WAIT(); asm volatile("" ::: "memory");
    const int c = lane & 7;
#pragma unroll
    for (int j = 0; j < 4; ++j) { const int n = (lane >> 3) + 8 * j; const LAS float* s = scr + (8 * c) * 33 + n;
        u32x4 o; o.x = cvtpk(s[0 * 33], s[1 * 33]); o.y = cvtpk(s[2 * 33], s[3 * 33]); o.z = cvtpk(s[4 * 33], s[5 * 33]); o.w = cvtpk(s[6 * 33], s[7 * 33]);
        *(u32x4*)(WT + (size_t)(n0 + n) * K + k0 + 8 * c) = o; }
    LDS_WAIT(); asm volatile("" ::: "memory");
}
template <bool OUTF> DI void rms_row(const float* xrow, const float* g, void* orow, int lane) {
    const f32x4* xr = (const f32x4*)xrow + lane; f32x4 v[8]; float s = 0.f;
#pragma unroll
    for (int j = 0; j < 8; ++j) { v[j] = xr[64 * j]; s += (v[j][0] * v[j][0] + v[j][1] * v[j][1]) + (v[j][2] * v[j][2] + v[j][3] * v[j][3]); }
    const float rstd = 1.0f / sqrtf(wave_sum(s) * (1.f / DM) + EPS);
#pragma unroll
    for (int j = 0; j < 8; ++j) { const f32x4 gv = ((const f32x4*)g)[lane + 64 * j]; const f32x4 o = v[j] * rstd * gv;
        if (OUTF) ((f32x4*)orow)[lane + 64 * j] = o;
        else ((u32x2*)orow)[lane + 64 * j] = (u32x2){cvtpk(o[0], o[1]), cvtpk(o[2], o[3])}; }
}
DI void rope_entry(float* CS, int idx) {
    const int p = idx >> 6, i = idx & 63; const float pos = (p == SEQ) ? (float)PAST : (float)p;
    const float ang = pos * ROPE_INV[i];
    const double a = (double)ang, q = __builtin_rint(a * 0.63661977236758134308);
    double r = __builtin_fma(-q, 1.57079632679489655800, a); r = __builtin_fma(-q, 6.12323399573676603587e-17, r);
    const double r2 = r * r;
    const double sp = r + r * r2 * (-1.0 / 6 + r2 * (1.0 / 120 + r2 * (-1.0 / 5040 + r2 * (1.0 / 362880 + r2 * (-1.0 / 39916800 + r2 * (1.0 / 6227020800.0))))));
    const double cp = 1.0 + r2 * (-0.5 + r2 * (1.0 / 24 + r2 * (-1.0 / 720 + r2 * (1.0 / 40320 + r2 * (-1.0 / 3628800 + r2 * (1.0 / 479001600.0 + r2 * (-1.0 / 87178291200.0)))))));
    const int n = (int)q & 3;
    const double c = (n == 0) ? cp : (n == 1) ? -sp : (n == 2) ? -cp : sp;
    const double s = (n == 0) ? sp : (n == 1) ? cp : (n == 2) ? -sp : -cp;
    CS[(size_t)p * 128 + i] = (float)c; CS[(size_t)p * 128 + 64 + i] = (float)s;
}
DI void p0_prologue(Frame& F) {
    LAS float* scr = (LAS float*)(F.lds + F.wave * 16384);
    const int gw = F.bid * NWAVES + F.wave, NGW = F.G * NWAVES;
    bf16_t* WT = (bf16_t*)(F.ws + WS_WT); bf16_t* WOT = (bf16_t*)(F.ws + WS_WOT); bf16_t* XN = (bf16_t*)(F.ws + WS_XN);
    constexpr int I_IN = (DM / 64) * (DINP / 32), I_OUT = (DM / 64) * (DM / 32);
    for (int it = gw; it < I_IN + I_OUT; it += NGW) {
        if (it < I_IN) p0_transpose_item(F.w_in, DM, DIN, WT, scr, it, DINP / 32, F.lane, [](int n) { return cmap_in(n); });
        else p0_transpose_item(F.w_out, DM, DM, WOT, scr, it - I_IN, DM / 32, F.lane, [](int n) { return n; });
    }
    for (int m = gw; m < MP; m += NGW) rms_row<false>(F.x + (size_t)m * DM, F.norm_g, XN + (size_t)m * DM, F.lane);
    if (F.bid == F.G - 1) rms_row<true>(F.xs + (size_t)F.wave * DM, F.norm_g, (float*)(F.ws + WS_XNS) + (size_t)F.wave * DM, F.lane);
    { const int gt = F.bid * NTHR + F.tid; float* CS = (float*)(F.ws + WS_CS);
      for (int idx = gt; idx < (SEQ + 1) * 64; idx += F.G * NTHR) rope_entry(CS, idx); }
}

DI void p1_sample_gemv(Frame& F) {
    LAS float* xs = (LAS float*)F.lds;
    const float* XNS = (const float*)(F.ws + WS_XNS);
    for (int i = F.tid; i < DB * DM / 4; i += NTHR) ((LAS f32x4*)xs)[i] = ((const f32x4*)XNS)[i];
    __syncthreads();
    const bf16_t* WT = (const bf16_t*)(F.ws + WS_WT); float* ZS = (float*)(F.ws + WS_ZS);
    const int gw = F.bid * NWAVES + F.wave, NGW = F.G * NWAVES, lane = F.lane;
    for (int n = gw; n < DIN; n += NGW) {
        asm volatile("" ::: "memory");
        const u32x4* wrow = (const u32x4*)(WT + (size_t)n * DM);
        float acc[8];
#pragma unroll
        for (int j = 0; j < 8; ++j) acc[j] = 0.f;
#pragma unroll
        for (int i = 0; i < 4; ++i) {
            const u32x4 w = wrow[lane + 64 * i];
            const float w0 = bflo(w.x), w1 = bfhi(w.x), w2 = bflo(w.y), w3 = bfhi(w.y), w4 = bflo(w.z), w5 = bfhi(w.z), w6 = bflo(w.w), w7 = bfhi(w.w);
#pragma unroll
            for (int j = 0; j < 8; ++j) {
                const LAS f32x4* xp = (const LAS f32x4*)(xs + j * DM + 8 * (lane + 64 * i));
                const f32x4 a = xp[0], b = xp[1];
                acc[j] += (a[0] * w0 + a[1] * w1) + (a[2] * w2 + a[3] * w3) + (b[0] * w4 + b[1] * w5) + (b[2] * w6 + b[3] * w7);
            }
        }
#pragma unroll
        for (int j = 0; j < 8; ++j) acc[j] = wave_sum(acc[j]);
        float r = acc[0];
#pragma unroll
        for (int j = 1; j < 8; ++j) r = (lane == j) ? acc[j] : r;
        if (lane < 8) ZS[(size_t)lane * DIN + cmap_in(n)] = r;
    }
    __syncthreads();
}

typedef LAS unsigned* lds_u32p;
DI void lds_inc(lds_u32p p) { (void)__hip_atomic_fetch_add(p, 1u, __ATOMIC_RELAXED, __HIP_MEMORY_SCOPE_WORKGROUP); }
DI void wave_radix_pass(const unsigned (&u)[32], lds_u32p H, int lane, unsigned mmask, unsigned mval, int shift, int need, int& bin, int& cabove, int& cbin) {
#pragma unroll
    for (int i = 0; i < 8; ++i) *(LAS u32x4*)(H + 4 * (lane + 64 * i)) = (u32x4){0u, 0u, 0u, 0u};
    asm volatile("s_waitcnt lgkmcnt(0)" ::: "memory");
#pragma unroll
    for (int i = 0; i < 32; ++i) if (u[i] != 0u && (u[i] & mmask) == mval) lds_inc(H + ((u[i] >> shift) & 2047u));
    asm volatile("s_waitcnt lgkmcnt(0)" ::: "memory");
    unsigned h[32];
#pragma unroll
    for (int i = 0; i < 8; ++i) { const u32x4 v = *(const LAS u32x4*)(H + 32 * lane + 4 * i); h[4 * i] = v.x; h[4 * i + 1] = v.y; h[4 * i + 2] = v.z; h[4 * i + 3] = v.w; }
    int s = 0;
#pragma unroll
    for (int i = 0; i < 32; ++i) s += (int)h[i];
    int x = s;
#pragma unroll
    for (int o = 1; o < 64; o <<= 1) { const int y = __shfl_down(x, o); x += (lane + o < 64) ? y : 0; }
    const int sex = x - s;
    const bool cross = (sex < need) && (sex + s >= need);
    int c = sex, bl = 0, ca = 0, cb = 0; bool found = false;
#pragma unroll
    for (int b = 31; b >= 0; --b) { const bool hit = !found && (c + (int)h[b] >= need); bl = hit ? b : bl; ca = hit ? c : ca; cb = hit ? (int)h[b] : cb; found = found || hit; c += (int)h[b]; }
    const unsigned long long m = __ballot(cross);
    const int L = (m != 0ull) ? (int)__builtin_ctzll(m) : 0;
    bin = __builtin_amdgcn_readlane(32 * lane + bl, L); cabove = __builtin_amdgcn_readlane(ca, L); cbin = __builtin_amdgcn_readlane(cb, L);
}
DI void p2_indexer_unit(Frame& F, int b, int j8, int mode = 7) {
    LAS char* L = (LAS char*)F.lds;
    LAS char* KB0 = L;
    LAS char* KB1 = L + 32768;
    LAS float* SC = (LAS float*)(L + 65536);
    const int tid = F.tid, lane = F.lane, w = F.wave, wm = w & 3, wn = w >> 2, hh = lane >> 5;
    const int t0 = 8 * j8, R0 = b * SEQ + t0, NT = ((t0 + 7) >> 7) + 1;
    const bf16_t* QI = (const bf16_t*)(F.ws + WS_QI); const bf16_t* KI = (const bf16_t*)(F.ws + WS_KI); const float* WI = (const float*)(F.ws + WS_WI);
    load_tile<128, false>(KB1, (const char*)(QI + (size_t)R0 * 2048), 256, tid);
    load_tile<128, false>(KB0, (const char*)(KI + (size_t)b * SEQ * 128), 256, tid);
    __syncthreads();
    bf16x8 qf[8];
#pragma unroll
    for (int s = 0; s < 8; ++s) qf[s] = row_frag(KB1, 32 * wm, lane, s);
    float wv[16];
#pragma unroll
    for (int r = 0; r < 16; ++r) wv[r] = WI[(size_t)(R0 + 2 * wm + (r >> 3)) * 16 + (r & 3) + 8 * ((r >> 2) & 1) + 4 * hh];
    __syncthreads();
    u32x4 kreg[4];
    for (int T = 0; T < ((mode & 1) ? NT : 0); ++T) {
        LAS char* KB = (T & 1) ? KB1 : KB0;
        if (T + 1 < NT) tile_fetch<128>(kreg, (const char*)(KI + ((size_t)b * SEQ + 128 * (T + 1)) * 128), 256, tid);
#pragma unroll
        for (int nb = 0; nb < 2; ++nb) {
            f32x16 acc = zero16();
#pragma unroll
            for (int s = 0; s < 8; ++s) acc = MFMA32(qf[s], row_frag(KB, 64 * wn + 32 * nb, lane, s), acc);
            float p0 = 0.f, p1 = 0.f;
#pragma unroll
            for (int r = 0; r < 8; ++r) { p0 += wv[r] * fmaxf(acc[r], 0.f); p1 += wv[8 + r] * fmaxf(acc[8 + r], 0.f); }
            const auto rr = __builtin_amdgcn_permlane32_swap(__float_as_uint(p0), __float_as_uint(p1), false, false);
            const int key = 128 * T + 64 * wn + 32 * nb + (lane & 31);
            SC[(2 * wm + hh) * 2048 + key] = __uint_as_float(rr[0]) + __uint_as_float(rr[1]);
        }
        if (T + 1 < NT) tile_put<128, false>((T & 1) ? KB0 : KB1, kreg, tid);
        __syncthreads();
    }
    if (!(mode & 2)) { __syncthreads(); return; }
    const int t = t0 + w; unsigned u[32];
#pragma unroll
    for (int i = 0; i < 32; ++i) { const int k = 64 * i + lane; u[i] = (k <= t) ? fkey(SC[w * 2048 + k]) : 0u; }
    unsigned long long* MASK = (unsigned long long*)(F.ws + WS_MASK) + (size_t)(R0 + w) * 32;
    const bool all = (t + 1 <= TOPK);
    unsigned T_sel = 0u, idx_cut = 0xffffffffu; bool tie = false;
    if (!all) {
        lds_u32p H = (lds_u32p)(L + w * 8192);
        int bin, ca, cb, need = TOPK;
        wave_radix_pass(u, H, lane, 0u, 0u, 21, need, bin, ca, cb);
        unsigned pre = (unsigned)bin << 21; need -= ca;
        if (need == cb) { T_sel = pre; }
        else {
            wave_radix_pass(u, H, lane, 0xffe00000u, pre, 10, need, bin, ca, cb);
            pre |= (unsigned)bin << 10; need -= ca;
            if (need == cb) { T_sel = pre; }
            else {
                wave_radix_pass(u, H, lane, 0xfffffc00u, pre, 0, need, bin, ca, cb);
                pre |= (unsigned)bin; need -= ca; T_sel = pre;
                if (need != cb) {
                    tie = true; unsigned lo = 0u, hi = 2047u;
                    while (lo < hi) { const unsigned mid = (lo + hi) >> 1; int c = 0;
#pragma unroll
                        for (int i = 0; i < 32; ++i) c += __popcll(__ballot(u[i] == pre && (unsigned)(64 * i + lane) <= mid));
                        if (c >= need) hi = mid; else lo = mid + 1u; }
                    idx_cut = lo;
                }
            }
        }
    }
#pragma unroll
    for (int i = 0; i < 32; ++i) {
        const unsigned k = 64 * i + lane; bool sel;
        if (all) sel = (int)k <= t;
        else if (!tie) sel = u[i] >= T_sel;
        else sel = (u[i] > T_sel) || (u[i] == T_sel && k <= idx_cut);
        const unsigned long long m = __ballot(sel);
        if (lane == 0 && (mode & 4)) MASK[i] = m;
    }
    __syncthreads();
}

DI void p2_retA_unit(Frame& F, int bh, int c) {
    LAS char* L = (LAS char*)F.lds; LAS char* KIMG = L; LAS char* VIMG = L + 32768;
    const int b = bh >> 3, h = bh & 7, R0 = b * SEQ + c * CH, lane = F.lane, w = F.wave, dt = w >> 1, eh = w & 1, hh = lane >> 5;
    const bf16_t* KR = (const bf16_t*)(F.ws + WS_KR); const bf16_t* VR = (const bf16_t*)(F.ws + WS_VR);
    load_tile<128, false>(KIMG, (const char*)(KR + (size_t)R0 * 1024 + h * 128), 2048, F.tid);
    load_tile<128, false>(VIMG, (const char*)(VR + (size_t)R0 * 1024 + h * 128), 2048, F.tid);
    __syncthreads();
    f32x16 acc[2] = {zero16(), zero16()};
#pragma unroll
    for (int ks = 0; ks < 8; ++ks) {
        const bf16x8 a = tr_frag(KIMG, 16 * ks, 32 * dt, lane);
#pragma unroll
        for (int e2 = 0; e2 < 2; ++e2) acc[e2] = MFMA32(a, tr_frag(VIMG, 16 * ks, 32 * (2 * eh + e2), lane), acc[e2]);
    }
    float* KV = (float*)(F.ws + WS_KV) + ((size_t)bh * NCH + c) * 16384;
#pragma unroll
    for (int e2 = 0; e2 < 2; ++e2)
#pragma unroll
        for (int r = 0; r < 16; ++r) KV[(32 * dt + crow(r, hh)) * 128 + 32 * (2 * eh + e2) + (lane & 31)] = acc[e2][r];
    __syncthreads();
}

DI void p2_sample_scores(Frame& F, int g) {
    const int b = g >> 5, lane = F.lane, key16 = lane & 15, gq = lane >> 4;
    const float* ZS = (const float*)(F.ws + WS_ZS) + (size_t)b * DIN;
    f32x4 qa[8];
#pragma unroll
    for (int t = 0; t < 8; ++t) qa[t] = *(const f32x4*)(ZS + C_QI + key16 * 128 + 16 * t + 4 * gq);
    float wv[4];
#pragma unroll
    for (int r = 0; r < 4; ++r) wv[r] = ZS[C_WI + 4 * gq + r] * WI_SCALE;
    float* SCS = (float*)(F.ws + WS_SCS) + (size_t)b * PAST;
    for (int grp = 0; grp < 4; ++grp) {
        const int s0 = 512 * (g & 31) + 64 * F.wave + 16 * grp, s = s0 + key16;
        const int page = F.ptab[b * NPAGES + (s >> 7)];
        const float* krow = F.cache_ki + ((size_t)page * PAGE + (s & 127)) * DIDX;
        f32x4 kb[8];
#pragma unroll
        for (int t = 0; t < 8; ++t) kb[t] = *(const f32x4*)(krow + 16 * t + 4 * gq);
        f32x4 acc = {0.f, 0.f, 0.f, 0.f};
#pragma unroll
        for (int t = 0; t < 8; ++t)
#pragma unroll
            for (int i = 0; i < 4; ++i) acc = __builtin_amdgcn_mfma_f32_16x16x4f32(qa[t][i], kb[t][i], acc, 0, 0, 0);
        float p = 0.f;
#pragma unroll
        for (int r = 0; r < 4; ++r) p += wv[r] * fmaxf(acc[r], 0.f);
        p += __shfl_xor(p, 16); p += __shfl_xor(p, 32);
        if (gq == 0) SCS[s] = p;
    }
}

DI void p2_sample_retention(Frame& F, int b, int h) {
    LAS float* LQ = (LAS float*)F.lds;
    LAS float* LK = LQ + 128; LAS float* LP = LQ + 256; LAS float* LO = LQ + 768;
    const float* ZS = (const float*)(F.ws + WS_ZS) + (size_t)b * DIN; const float* CS = (const float*)(F.ws + WS_CS) + (size_t)SEQ * 128;
    const int tid = F.tid;
    if (tid < 64) {
        const float c = CS[tid], s = CS[64 + tid];
        const float q1 = ZS[C_QR + h * 128 + tid], q2 = ZS[C_QR + h * 128 + 64 + tid], k1 = ZS[C_KR + h * 128 + tid], k2 = ZS[C_KR + h * 128 + 64 + tid];
        LQ[tid] = q1 * c - q2 * s; LQ[64 + tid] = q1 * s + q2 * c;
        LK[tid] = (k1 * c - k2 * s) * KSCALE; LK[64 + tid] = (k1 * s + k2 * c) * KSCALE;
    }
    __syncthreads();
    const int e = tid & 127, dq = tid >> 7; const float gam = 1.0f - __builtin_amdgcn_exp2f((float)(-5 - h));
    const float v = ZS[C_VR + h * 128 + e];
    const float* S = F.state + ((size_t)(b * NRH + h)) * 16384; float* SN = F.out + O_STS + ((size_t)(b * NRH + h)) * 16384;
    float part = 0.f;
#pragma unroll
    for (int dd = 0; dd < 32; ++dd) { const int d = 32 * dq + dd; const float sv = S[d * 128 + e]; part += LQ[d] * sv; SN[d * 128 + e] = gam * sv + LK[d] * v; }
    LP[dq * 128 + e] = part;
    __syncthreads();
    if (tid < 128) {
        float qk = 0.f;
#pragma unroll 8
        for (int d = 0; d < 128; ++d) qk += LQ[d] * LK[d];
        LO[tid] = qk * v + gam * ((LP[tid] + LP[128 + tid]) + (LP[256 + tid] + LP[384 + tid]));
    }
    __syncthreads();
    if (F.wave == 0) {
        const float o0 = LO[F.lane], o1 = LO[64 + F.lane];
        const float mu = wave_sum(o0 + o1) * (1.f / 128); const float d0 = o0 - mu, d1 = o1 - mu;
        const float rs = 1.0f / sqrtf(wave_sum(d0 * d0 + d1 * d1) * (1.f / 128) + EPS);
        float* ACTS = (float*)(F.ws + WS_ACTS) + (size_t)b * DM + h * 128;
        ACTS[F.lane] = d0 * rs * F.ret_g[h * 128 + F.lane] * silu(ZS[C_GR + h * 128 + F.lane]);
        ACTS[64 + F.lane] = d1 * rs * F.ret_g[h * 128 + 64 + F.lane] * silu(ZS[C_GR + h * 128 + 64 + F.lane]);
    }
    __syncthreads();
}

DI void p3_scan(Frame& F) {
    const int gt = F.bid * NTHR + F.tid;
    if (gt >= 32 * 4096) return;
    const int bh = gt >> 12, e4 = (gt & 4095) * 4, h = bh & 7;
    const float g128 = __builtin_amdgcn_exp2f(128.f * l2g(h));
    const float* KV = (const float*)(F.ws + WS_KV) + (size_t)bh * NCH * 16384 + e4; bf16_t* SP = (bf16_t*)(F.ws + WS_SP) + (size_t)bh * NCH * 16384 + e4;
    f32x4 S = {0.f, 0.f, 0.f, 0.f};
#pragma unroll 4
    for (int c = 0; c < NCH; ++c) {
        S = (S + *(const f32x4*)(KV + (size_t)c * 16384)) * g128;
        if (c + 1 < NCH) *(u32x2*)(SP + (size_t)(c + 1) * 16384) = (u32x2){cvtpk(S[0], S[1]), cvtpk(S[2], S[3])};
    }
    *(f32x4*)(F.out + O_ST + (size_t)bh * 16384 + e4) = S;
}

DI void wg_radix_pass(const unsigned (&u)[33], lds_u32p H, lds_u32p LW, int tid, int lane, int w, unsigned mmask, unsigned mval, int shift, int need, int& bin, int& cabove, int& cbin) {
    *(LAS u32x4*)(H + 4 * tid) = (u32x4){0u, 0u, 0u, 0u};
    __syncthreads();
#pragma unroll
    for (int i = 0; i < 33; ++i) if (u[i] != 0u && (u[i] & mmask) == mval) lds_inc(H + ((u[i] >> shift) & 2047u));
    __syncthreads();
    const u32x4 h = *(const LAS u32x4*)(H + 4 * tid);
    const int hv[4] = {(int)h.x, (int)h.y, (int)h.z, (int)h.w};
    const int s = (hv[0] + hv[1]) + (hv[2] + hv[3]);
    int x = s;
#pragma unroll
    for (int o = 1; o < 64; o <<= 1) { const int y = __shfl_down(x, o); x += (lane + o < 64) ? y : 0; }
    if (lane == 0) LW[w] = (unsigned)x;
    __syncthreads();
    int above = 0;
#pragma unroll
    for (int i = 0; i < 8; ++i) above += (i > w) ? (int)LW[i] : 0;
    const int sex = (x - s) + above;
    if ((sex < need) && (sex + s >= need)) {
        int c = sex, bl = 0, ca = 0, cb = 0; bool found = false;
#pragma unroll
        for (int b = 3; b >= 0; --b) { const bool hit = !found && (c + hv[b] >= need); bl = hit ? b : bl; ca = hit ? c : ca; cb = hit ? hv[b] : cb; found = found || hit; c += hv[b]; }
        LW[8] = (unsigned)(4 * tid + bl); LW[9] = (unsigned)ca; LW[10] = (unsigned)cb;
    }
    __syncthreads();
    bin = (int)LW[8]; cabove = (int)LW[9]; cbin = (int)LW[10];
    __syncthreads();
}
DI int wg_count(LAS unsigned* LU, int w, int lane, int c) {
    if (lane == 0) LU[w] = (unsigned)c;
    __syncthreads();
    int tot = 0;
#pragma unroll
    for (int i = 0; i < 8; ++i) tot += (int)LU[i];
    __syncthreads();
    return tot;
}
DI void p3_sample_attend(Frame& F, int b) {
    LAS unsigned* LU = (LAS unsigned*)F.lds;
    LAS int* LIST = (LAS int*)(F.lds + 256);
    LAS int* LROW = (LAS int*)(F.lds + 1280);
    LAS float* LG = (LAS float*)(F.lds + 4096);
    LAS float* LQA = (LAS float*)(F.lds + 12288);
    LAS float* LRED = (LAS float*)(F.lds + 16384);
    const int tid = F.tid, lane = F.lane, w = F.wave;
    const float* ZS = (const float*)(F.ws + WS_ZS) + (size_t)b * DIN; const float* SCS = (const float*)(F.ws + WS_SCS) + (size_t)b * PAST;
    for (int i = tid; i < 1024; i += NTHR) LQA[i] = ZS[C_QA + i];
    if (w == 0) {
        const int hh = lane >> 2, qd = lane & 3; float p = 0.f;
#pragma unroll 8
        for (int d = 0; d < 32; ++d) p += ZS[C_QI + hh * 128 + 32 * qd + d] * ZS[C_KI + 32 * qd + d];
        p += __shfl_xor(p, 1); p += __shfl_xor(p, 2);
        float sc = ZS[C_WI + hh] * WI_SCALE * fmaxf(p, 0.f);
        sc += __shfl_xor(sc, 4); sc += __shfl_xor(sc, 8); sc += __shfl_xor(sc, 16); sc += __shfl_xor(sc, 32);
        if (lane == 0) LU[16] = fkey(sc);
    }
    __syncthreads();
    unsigned u[33];
#pragma unroll
    for (int i = 0; i < 32; ++i) u[i] = fkey(SCS[tid + 512 * i]);
    u[32] = (tid == 0) ? LU[16] : 0u;
    lds_u32p H = (lds_u32p)(F.lds + 65536);
    unsigned prefix = 0u, idx_cut = 0xffffffffu; bool exact = true;
    {
        int bin, ca, cb, need = TOPK;
        wg_radix_pass(u, H, LU, tid, lane, w, 0u, 0u, 21, need, bin, ca, cb);
        prefix = (unsigned)bin << 21; need -= ca;
        if (need != cb) {
            wg_radix_pass(u, H, LU, tid, lane, w, 0xffe00000u, prefix, 10, need, bin, ca, cb);
            prefix |= (unsigned)bin << 10; need -= ca;
            if (need != cb) {
                wg_radix_pass(u, H, LU, tid, lane, w, 0xfffffc00u, prefix, 0, need, bin, ca, cb);
                prefix |= (unsigned)bin; need -= ca;
                if (need != cb) {
                    exact = false; unsigned lo = 0u, hi = (unsigned)PAST;
                    while (lo < hi) {
                        const unsigned mid = (lo + hi) >> 1; int cc = 0;
#pragma unroll
                        for (int i = 0; i < 33; ++i) cc += __popcll(__ballot(u[i] == prefix && (unsigned)(tid + 512 * i) <= mid));
                        if (wg_count(LU, w, lane, cc) >= need) hi = mid; else lo = mid + 1u;
                    }
                    idx_cut = lo;
                }
            }
        }
    }
    int mycnt = 0;
#pragma unroll
    for (int i = 0; i < 33; ++i) { const bool sel = exact ? (u[i] >= prefix && u[i] != 0u) : ((u[i] > prefix) || (u[i] == prefix && (unsigned)(tid + 512 * i) <= idx_cut)); mycnt += __popcll(__ballot(sel)); }
    if (lane == 0) LU[w] = (unsigned)mycnt;
    __syncthreads();
    int base = 0;
#pragma unroll
    for (int i = 0; i < 8; ++i) base += (i < w) ? (int)LU[i] : 0;
#pragma unroll
    for (int i = 0; i < 33; ++i) {
        const bool sel = exact ? (u[i] >= prefix && u[i] != 0u) : ((u[i] > prefix) || (u[i] == prefix && (unsigned)(tid + 512 * i) <= idx_cut));
        const unsigned long long m = __ballot(sel);
        if (sel) { const int pos = base + __popcll(m & ((1ull << lane) - 1ull)); if (pos < TOPK) LIST[pos] = tid + 512 * i; }
        base += __popcll(m);
    }
    __syncthreads();
    if (tid < TOPK) { const int idx = LIST[tid]; int rb = -1; if (idx < PAST) { const int page = F.ptab[b * NPAGES + (idx >> 7)]; rb = (page * PAGE + (idx & 127)) * (NKV * HD); } LROW[tid] = rb; }
    __syncthreads();
    {
        const int kk = tid >> 1, c = tid & 1, rb = LROW[kk];
        const float* krow = (rb >= 0) ? (F.cache_k + (size_t)rb + c * HD) : (ZS + C_KA + c * HD);
        float a0 = 0.f, a1 = 0.f, a2 = 0.f, a3 = 0.f;
        const LAS float* q = LQA + (4 * c) * 128;
#pragma unroll 16
        for (int d4 = 0; d4 < 32; ++d4) {
            const f32x4 kv = *(const f32x4*)(krow + 4 * d4);
            const f32x4 q0 = *(const LAS f32x4*)(q + 4 * d4), q1 = *(const LAS f32x4*)(q + 128 + 4 * d4), q2 = *(const LAS f32x4*)(q + 256 + 4 * d4), q3 = *(const LAS f32x4*)(q + 384 + 4 * d4);
            a0 += (kv[0] * q0[0] + kv[1] * q0[1]) + (kv[2] * q0[2] + kv[3] * q0[3]);
            a1 += (kv[0] * q1[0] + kv[1] * q1[1]) + (kv[2] * q1[2] + kv[3] * q1[3]);
            a2 += (kv[0] * q2[0] + kv[1] * q2[1]) + (kv[2] * q2[2] + kv[3] * q2[3]);
            a3 += (kv[0] * q3[0] + kv[1] * q3[1]) + (kv[2] * q3[2] + kv[3] * q3[3]);
        }
        LG[(4 * c + 0) * 256 + kk] = a0 * KSCALE; LG[(4 * c + 1) * 256 + kk] = a1 * KSCALE; LG[(4 * c + 2) * 256 + kk] = a2 * KSCALE; LG[(4 * c + 3) * 256 + kk] = a3 * KSCALE;
    }
    __syncthreads();
    {
        float l[4]; float mx = -3.0e38f;
#pragma unroll
        for (int i = 0; i < 4; ++i) { l[i] = LG[w * 256 + lane + 64 * i]; mx = fmaxf(mx, l[i]); }
#pragma unroll
        for (int o = 1; o < 64; o <<= 1) mx = fmaxf(mx, __shfl_xor(mx, o));
        float sum = 0.f;
#pragma unroll
        for (int i = 0; i < 4; ++i) { l[i] = __expf(l[i] - mx); sum += l[i]; }
        sum = wave_sum(sum); const float inv = 1.0f / sum;
#pragma unroll
        for (int i = 0; i < 4; ++i) LG[w * 256 + lane + 64 * i] = l[i] * inv;
    }
    __syncthreads();
    {
        const int c = tid >> 8, kg = (tid >> 5) & 7, d4 = tid & 31;
        f32x4 o[4];
#pragma unroll
        for (int h4 = 0; h4 < 4; ++h4) o[h4] = (f32x4){0.f, 0.f, 0.f, 0.f};
#pragma unroll 8
        for (int i = 0; i < 32; ++i) {
            const int kk = kg + 8 * i, rb = LROW[kk];
            const float* vrow = (rb >= 0) ? (F.cache_v + (size_t)rb + c * HD) : (ZS + C_VA + c * HD);
            const f32x4 vv = *(const f32x4*)(vrow + 4 * d4);
#pragma unroll
            for (int h4 = 0; h4 < 4; ++h4) o[h4] = o[h4] + vv * LG[(4 * c + h4) * 256 + kk];
        }
#pragma unroll
        for (int h4 = 0; h4 < 4; ++h4) *(LAS f32x4*)(LRED + (kg * 8 + 4 * c + h4) * 128 + 4 * d4) = o[h4];
    }
    __syncthreads();
    {
        float* ACTS = (float*)(F.ws + WS_ACTS) + (size_t)b * DM + 1024;
#pragma unroll
        for (int r = 0; r < 2; ++r) {
            const int e = tid + 512 * r; float s = 0.f;
#pragma unroll
            for (int kg = 0; kg < 8; ++kg) s += LRED[kg * 1024 + e];
            ACTS[e] = s * silu(ZS[C_GA + e]);
        }
    }
    __syncthreads();
}

DI void p4_attn_unit(Frame& F, int b, int j16, int mode = 7) {
    LAS char* L = (LAS char*)F.lds;
    const int tid = F.tid, lane = F.lane, w = F.wave, c = w >> 2, q16 = lane & 15, g = lane >> 4;
    const int t0 = 16 * j16, R0 = b * SEQ + t0, NT = (t0 >> 6) + 1;
    const bf16_t* QA = (const bf16_t*)(F.ws + WS_QA); const bf16_t* KA = (const bf16_t*)(F.ws + WS_KA); const bf16_t* VA = (const bf16_t*)(F.ws + WS_VA);
    const unsigned long long* MASK = (const unsigned long long*)(F.ws + WS_MASK) + (size_t)(R0 + q16) * 32;
    bf16x8 qf[4];
#pragma unroll
    for (int s = 0; s < 4; ++s) qf[s] = *(const bf16x8*)(QA + (size_t)(R0 + q16) * 1024 + w * 128 + 32 * s + 8 * g);
    f32x4 ot[8];
#pragma unroll
    for (int i = 0; i < 8; ++i) ot[i] = (f32x4){0.f, 0.f, 0.f, 0.f};
    float mrun = -1.0e30f, lrun = 0.f;
    u32x4 kr[4], vr[4];
#define ATT_FETCH(T_) do { const char* kg = (const char*)(KA + ((size_t)b * SEQ + 64 * (T_)) * 256); const char* vg = (const char*)(VA + ((size_t)b * SEQ + 64 * (T_)) * 256); \
        _Pragma("unroll") for (int i = 0; i < 4; ++i) { const int n = tid + 512 * i, row = n >> 5, cc = (n >> 4) & 1, ch = n & 15; \
            kr[i] = *(const u32x4*)(kg + (size_t)row * 512 + cc * 256 + ch * 16); vr[i] = *(const u32x4*)(vg + (size_t)row * 512 + cc * 256 + ch * 16); } } while (0)
#define ATT_PUT(buf_) do { _Pragma("unroll") for (int i = 0; i < 4; ++i) { const int n = tid + 512 * i, row = n >> 5, cc = (n >> 4) & 1, ch = n & 15; \
            *(LAS u32x4*)(L + (buf_) * 65536 + cc * 16384 + tile_off(row, ch)) = kr[i]; *(LAS u32x4*)(L + (buf_) * 65536 + 32768 + cc * 16384 + vtile_off(row, ch)) = vr[i]; } } while (0)
    ATT_FETCH(0); ATT_PUT(0);
    __syncthreads();
    for (int T = 0; T < NT; ++T) {
        LAS char* KIMG = L + (T & 1) * 65536; LAS char* VIMG = KIMG + 32768;
        if ((mode & 1) && T + 1 < NT) ATT_FETCH(T + 1);
        if (mode & 2) {
        const unsigned long long mw = MASK[T] >> (4 * g);
        const unsigned mlo = (unsigned)mw, mhi = (unsigned)(mw >> 32);
        f32x4 st[4];
#pragma unroll
        for (int kb = 0; kb < 4; ++kb) {
            st[kb] = (f32x4){0.f, 0.f, 0.f, 0.f};
#pragma unroll
            for (int s = 0; s < 4; ++s) st[kb] = MFMA16(row_frag16(KIMG + c * 16384, 16 * kb, lane, s), qf[s], st[kb]);
        }
        float mt = -1.0e30f;
#pragma unroll
        for (int kb = 0; kb < 4; ++kb)
#pragma unroll
            for (int r = 0; r < 4; ++r) { const unsigned bit = ((kb < 2 ? mlo : mhi) >> (16 * (kb & 1) + r)) & 1u; st[kb][r] = bit ? st[kb][r] : -1.0e30f; mt = fmaxf(mt, st[kb][r]); }
        mt = fmaxf(mt, __shfl_xor(mt, 16)); mt = fmaxf(mt, __shfl_xor(mt, 32));
        const float mnew = fmaxf(mrun, mt), alpha = __builtin_amdgcn_exp2f(mrun - mnew);
        mrun = mnew; lrun *= alpha;
#pragma unroll
        for (int i = 0; i < 8; ++i) ot[i] = ot[i] * alpha;
        float ps = 0.f;
#pragma unroll
        for (int kb = 0; kb < 4; ++kb)
#pragma unroll
            for (int r = 0; r < 4; ++r) { const float p = (st[kb][r] > -0.5e30f) ? __builtin_amdgcn_exp2f(st[kb][r] - mnew) : 0.f; st[kb][r] = p; ps += p; }
        lrun += ps;
#pragma unroll
        for (int ks = 0; ks < 2; ++ks) {
            const u32x4 pw = {cvtpk(st[2 * ks][0], st[2 * ks][1]), cvtpk(st[2 * ks][2], st[2 * ks][3]), cvtpk(st[2 * ks + 1][0], st[2 * ks + 1][1]), cvtpk(st[2 * ks + 1][2], st[2 * ks + 1][3])};
            const bf16x8 pb = __builtin_bit_cast(bf16x8, pw);
#pragma unroll
            for (int c8 = 0; c8 < 8; ++c8) ot[c8] = MFMA16(tr16_perm(VIMG + c * 16384, 32 * ks, c8, lane), pb, ot[c8]);
        }
        }
        if ((mode & 1) && T + 1 < NT) ATT_PUT((T + 1) & 1);
        __syncthreads();
    }
#undef ATT_FETCH
#undef ATT_PUT
    lrun += __shfl_xor(lrun, 16); lrun += __shfl_xor(lrun, 32);
    if (!(mode & 4)) return;
    const float inv = 1.0f / lrun;
    const bf16_t* GA = (const bf16_t*)(F.ws + WS_GA) + (size_t)(R0 + q16) * 1024 + w * 128; bf16_t* ACT = (bf16_t*)(F.ws + WS_ACT) + (size_t)(R0 + q16) * DM + 1024 + w * 128;
#pragma unroll
    for (int c8 = 0; c8 < 8; ++c8) {
        const int d = 16 * c8 + 4 * g; const u32x2 gw = *(const u32x2*)(GA + d);
        const float o0 = ot[c8][0] * inv * bflo(gw.x), o1 = ot[c8][1] * inv * bfhi(gw.x), o2 = ot[c8][2] * inv * bflo(gw.y), o3 = ot[c8][3] * inv * bfhi(gw.y);
        *(u32x2*)(ACT + d) = (u32x2){cvtpk(o0, o1), cvtpk(o2, o3)};
    }
}

DI void p4_attn_pair(Frame& F, int b, int jj, int mode = 7) {
    LAS char* L = (LAS char*)F.lds;
    const int tid = F.tid, lane = F.lane, w = F.wave, set = w >> 2, hp = w & 3, c = hp >> 1, r32 = lane & 31, hh = lane >> 5, q = r32 & 15, head = 2 * hp + (r32 >> 4);
    const int t0 = set ? 16 * (127 - jj) : 16 * jj, R0 = b * SEQ + t0, NTA = ((16 * jj) >> 6) + 1, NTB = ((16 * (127 - jj)) >> 6) + 1, NTme = set ? NTB : NTA;
    const bf16_t* QA = (const bf16_t*)(F.ws + WS_QA); const bf16_t* KA = (const bf16_t*)(F.ws + WS_KA); const bf16_t* VA = (const bf16_t*)(F.ws + WS_VA);
    const unsigned long long* MASK = (const unsigned long long*)(F.ws + WS_MASK) + (size_t)(R0 + q) * 32;
    bf16x8 qf[8];
#pragma unroll
    for (int s = 0; s < 8; ++s) qf[s] = *(const bf16x8*)(QA + (size_t)(R0 + q) * 1024 + head * 128 + 16 * s + 8 * hh);
    f32x16 ot[4] = {zero16(), zero16(), zero16(), zero16()};
    float mrun = -1.0e30f, lrun = 0.f;
    u32x4 kr[4], vr[4];
#define ATT_FETCH(T_) do { const char* kg = (const char*)(KA + ((size_t)b * SEQ + 64 * (T_)) * 256); const char* vg = (const char*)(VA + ((size_t)b * SEQ + 64 * (T_)) * 256); \
        _Pragma("unroll") for (int i = 0; i < 4; ++i) { const int n = tid + 512 * i, row = n >> 5, cc = (n >> 4) & 1, ch = n & 15; \
            kr[i] = *(const u32x4*)(kg + (size_t)row * 512 + cc * 256 + ch * 16); vr[i] = *(const u32x4*)(vg + (size_t)row * 512 + cc * 256 + ch * 16); } } while (0)
#define ATT_PUT(buf_) do { _Pragma("unroll") for (int i = 0; i < 4; ++i) { const int n = tid + 512 * i, row = n >> 5, cc = (n >> 4) & 1, ch = n & 15; \
            *(LAS u32x4*)(L + (buf_) * 65536 + cc * 16384 + tile_off(row, ch)) = kr[i]; *(LAS u32x4*)(L + (buf_) * 65536 + 32768 + cc * 16384 + tile_off(row, ch)) = vr[i]; } } while (0)
    ATT_FETCH(0); ATT_PUT(0);
    __syncthreads();
    for (int T = 0; T < NTB; ++T) {
        const LAS char* KIMG = L + (T & 1) * 65536 + c * 16384; const LAS char* VIMG = L + (T & 1) * 65536 + 32768 + c * 16384;
        if ((mode & 1) && T + 1 < NTB) ATT_FETCH(T + 1);
        if ((mode & 2) && T < NTme) {
            const unsigned long long mw = MASK[T] >> (4 * hh);
            const unsigned mlo = (unsigned)mw, mhi = (unsigned)(mw >> 32);
            f32x16 st[2];
#pragma unroll
            for (int kb = 0; kb < 2; ++kb) {
                st[kb] = zero16();
#pragma unroll
                for (int s = 0; s < 8; ++s) st[kb] = MFMA32(row_frag(KIMG, 32 * kb, lane, s), qf[s], st[kb]);
                asm volatile("" ::: "memory");
            }
            float mt = fmaxf(st[0][0], st[1][0]);
#pragma unroll
            for (int r = 1; r < 16; ++r) mt = fmaxf(mt, fmaxf(st[0][r], st[1][r]));
            { const auto rr = __builtin_amdgcn_permlane32_swap(__float_as_uint(mt), __float_as_uint(mt), false, false); mt = fmaxf(__uint_as_float(rr[0]), __uint_as_float(rr[1])); }
            if (__any(mt > mrun + 8.0f)) {
                const float mnew = fmaxf(mrun, mt), alpha = __builtin_amdgcn_exp2f(mrun - mnew);
                mrun = mnew; lrun *= alpha;
#pragma unroll
                for (int i = 0; i < 4; ++i) ot[i] = ot[i] * alpha;
            }
            float ps = 0.f;
#pragma unroll
            for (int kb = 0; kb < 2; ++kb)
#pragma unroll
                for (int r = 0; r < 16; ++r) {
                    const unsigned bit = ((kb ? mhi : mlo) >> ((r & 3) + 8 * (r >> 2))) & 1u;
                    const float p = bit ? __builtin_amdgcn_exp2f(st[kb][r] - mrun) : 0.f; st[kb][r] = p; ps += p;
                }
            lrun += ps;
#pragma unroll
            for (int s2 = 0; s2 < 4; ++s2) {
                const int kb = s2 >> 1, o8 = 8 * (s2 & 1);
                const u32x4 pw = {cvtpk(st[kb][o8 + 0], st[kb][o8 + 1]), cvtpk(st[kb][o8 + 2], st[kb][o8 + 3]), cvtpk(st[kb][o8 + 4], st[kb][o8 + 5]), cvtpk(st[kb][o8 + 6], st[kb][o8 + 7])};
                const bf16x8 pb = __builtin_bit_cast(bf16x8, pw);
#pragma unroll
                for (int db = 0; db < 4; ++db) ot[db] = MFMA32(tr_frag_perm(VIMG, 16 * s2, 32 * db, lane), pb, ot[db]);
                asm volatile("" ::: "memory");
            }
        }
        if ((mode & 1) && T + 1 < NTB) ATT_PUT((T + 1) & 1);
        __syncthreads();
    }
#undef ATT_FETCH
#undef ATT_PUT
    if (!(mode & 4)) return;
    { const auto rr = __builtin_amdgcn_permlane32_swap(__float_as_uint(lrun), __float_as_uint(lrun), false, false); lrun = __uint_as_float(rr[0]) + __uint_as_float(rr[1]); }
    const float inv = 1.0f / lrun;
    const bf16_t* GA = (const bf16_t*)(F.ws + WS_GA) + (size_t)(R0 + q) * 1024 + head * 128; bf16_t* ACT = (bf16_t*)(F.ws + WS_ACT) + (size_t)(R0 + q) * DM + 1024 + head * 128;
#pragma unroll
    for (int db = 0; db < 4; ++db)
#pragma unroll
        for (int r4 = 0; r4 < 4; ++r4) {
            const int d = 32 * db + 8 * r4 + 4 * hh; const u32x2 gw = *(const u32x2*)(GA + d);
            const float o0 = ot[db][4 * r4 + 0] * inv * bflo(gw.x), o1 = ot[db][4 * r4 + 1] * inv * bfhi(gw.x), o2 = ot[db][4 * r4 + 2] * inv * bflo(gw.y), o3 = ot[db][4 * r4 + 3] * inv * bfhi(gw.y);
            *(u32x2*)(ACT + d) = (u32x2){cvtpk(o0, o1), cvtpk(o2, o3)};
        }
}

DI void p4_attn_unit32(Frame& F, int b, int c, int j32, int mode = 7) {
    LAS char* L = (LAS char*)F.lds;
    const int tid = F.tid, lane = F.lane, w = F.wave, h4 = w & 3, kh = w >> 2, r32 = lane & 31, hh = lane >> 5, head = 4 * c + h4;
    const int t0 = 32 * j32, R0 = b * SEQ + t0, NT = (j32 >> 1) + 1;
    const bf16_t* QA = (const bf16_t*)(F.ws + WS_QA); const bf16_t* KA = (const bf16_t*)(F.ws + WS_KA); const bf16_t* VA = (const bf16_t*)(F.ws + WS_VA);
    const unsigned long long* MASK = (const unsigned long long*)(F.ws + WS_MASK) + (size_t)(R0 + r32) * 32;
    bf16x8 qf[8];
#pragma unroll
    for (int s = 0; s < 8; ++s) qf[s] = *(const bf16x8*)(QA + (size_t)(R0 + r32) * 1024 + head * 128 + 16 * s + 8 * hh);
    f32x16 ot[4] = {zero16(), zero16(), zero16(), zero16()};
    float mrun = -1.0e30f, lrun = 0.f;
    u32x4 kr[2], vr[2];
#define ATT_FETCH(T_) do { const char* kg = (const char*)(KA + ((size_t)b * SEQ + 64 * (T_)) * 256 + c * 128); const char* vg = (const char*)(VA + ((size_t)b * SEQ + 64 * (T_)) * 256 + c * 128); \
        _Pragma("unroll") for (int i = 0; i < 2; ++i) { const int n = tid + 512 * i, row = n >> 4, ch = n & 15; \
            kr[i] = *(const u32x4*)(kg + (size_t)row * 512 + ch * 16); vr[i] = *(const u32x4*)(vg + (size_t)row * 512 + ch * 16); } } while (0)
#define ATT_PUT(buf_) do { _Pragma("unroll") for (int i = 0; i < 2; ++i) { const int n = tid + 512 * i, row = n >> 4, ch = n & 15; \
            *(LAS u32x4*)(L + (buf_) * 32768 + tile_off(row, ch)) = kr[i]; *(LAS u32x4*)(L + (buf_) * 32768 + 16384 + tile_off(row, ch)) = vr[i]; } } while (0)
    __syncthreads();
    unsigned long long mw_cur = MASK[0], mw_nx = 0ull;
    ATT_FETCH(0); ATT_PUT(0);
    __syncthreads();
    for (int T = 0; T < NT; ++T) {
        const LAS char* KIMG = L + (T & 1) * 32768; const LAS char* VIMG = KIMG + 16384;
        if (T + 1 < NT) mw_nx = MASK[T + 1];
        if ((mode & 1) && T + 1 < NT) ATT_FETCH(T + 1);
        if (mode & 2) {
            const unsigned long long mw = mw_cur >> (4 * hh);
            const unsigned mbits = kh ? (unsigned)(mw >> 32) : (unsigned)mw;
            f32x16 st = zero16();
#pragma unroll
            for (int s = 0; s < 8; ++s) st = MFMA32(row_frag(KIMG, 32 * kh, lane, s), qf[s], st);
            float mt = st[0];
#pragma unroll
            for (int r = 1; r < 16; ++r) mt = fmaxf(mt, st[r]);
            { const auto rr = __builtin_amdgcn_permlane32_swap(__float_as_uint(mt), __float_as_uint(mt), false, false); mt = fmaxf(__uint_as_float(rr[0]), __uint_as_float(rr[1])); }
            if (__any(mt > mrun + 8.0f)) {
                const float mnew = fmaxf(mrun, mt), alpha = __builtin_amdgcn_exp2f(mrun - mnew);
                mrun = mnew; lrun *= alpha;
#pragma unroll
                for (int i = 0; i < 4; ++i) ot[i] = ot[i] * alpha;
            }
            float ps = 0.f;
#pragma unroll
            for (int r = 0; r < 16; ++r) {
                const unsigned bit = (mbits >> ((r & 3) + 8 * (r >> 2))) & 1u;
                const float p = bit ? __builtin_amdgcn_exp2f(st[r] - mrun) : 0.f; st[r] = p; ps += p;
            }
            lrun += ps;
#pragma unroll
            for (int s2 = 0; s2 < 2; ++s2) {
                const int o8 = 8 * s2;
                const u32x4 pw = {cvtpk(st[o8 + 0], st[o8 + 1]), cvtpk(st[o8 + 2], st[o8 + 3]), cvtpk(st[o8 + 4], st[o8 + 5]), cvtpk(st[o8 + 6], st[o8 + 7])};
                const bf16x8 pb = __builtin_bit_cast(bf16x8, pw);
#pragma unroll
                for (int db = 0; db < 4; ++db) ot[db] = MFMA32(tr_frag_perm(VIMG, 32 * kh + 16 * s2, 32 * db, lane), pb, ot[db]);
            }
        }
        if ((mode & 1) && T + 1 < NT) ATT_PUT((T + 1) & 1);
        mw_cur = mw_nx;
        __syncthreads();
    }
#undef ATT_FETCH
#undef ATT_PUT
    LAS float* MB = (LAS float*)L + h4 * 4224;
    if (kh == 1) {
#pragma unroll
        for (int db = 0; db < 4; ++db)
#pragma unroll
            for (int r = 0; r < 16; ++r) MB[(16 * db + r) * 64 + lane] = ot[db][r];
        MB[4096 + lane] = mrun; MB[4160 + lane] = lrun;
    }
    __syncthreads();
    if (kh == 0 && (mode & 4)) {
        const float m1 = MB[4096 + lane], l1 = MB[4160 + lane];
        const float m = fmaxf(mrun, m1), a0 = __builtin_amdgcn_exp2f(mrun - m), a1 = __builtin_amdgcn_exp2f(m1 - m);
        float l = lrun * a0 + l1 * a1;
        { const auto rr = __builtin_amdgcn_permlane32_swap(__float_as_uint(l), __float_as_uint(l), false, false); l = __uint_as_float(rr[0]) + __uint_as_float(rr[1]); }
        const float inv = 1.0f / l;
        const bf16_t* GA = (const bf16_t*)(F.ws + WS_GA) + (size_t)(R0 + r32) * 1024 + head * 128; bf16_t* ACT = (bf16_t*)(F.ws + WS_ACT) + (size_t)(R0 + r32) * DM + 1024 + head * 128;
#pragma unroll
        for (int db = 0; db < 4; ++db)
#pragma unroll
            for (int r4 = 0; r4 < 4; ++r4) {
                const int d = 32 * db + 8 * r4 + 4 * hh; const u32x2 gw = *(const u32x2*)(GA + d);
                float o[4];
#pragma unroll
                for (int e = 0; e < 4; ++e) o[e] = (ot[db][4 * r4 + e] * a0 + MB[(16 * db + 4 * r4 + e) * 64 + lane] * a1) * inv;
                *(u32x2*)(ACT + d) = (u32x2){cvtpk(o[0] * bflo(gw.x), o[1] * bfhi(gw.x)), cvtpk(o[2] * bflo(gw.y), o[3] * bfhi(gw.y))};
            }
    }
    __syncthreads();
}

DI void p4_retB_unit(Frame& F, int bh, int c) {
    LAS char* L = (LAS char*)F.lds; LAS char* QIMG = L; LAS char* KIMG = L + 32768; LAS char* VIMG = L + 65536; LAS char* SIMG = L + 98304;
    LAS float* OUT = (LAS float*)L;
    const int b = bh >> 3, h = bh & 7, R0 = b * SEQ + c * CH, tid = F.tid, lane = F.lane, w = F.wave, it = w >> 1, eh = w & 1, hh = lane >> 5;
    const bf16_t* QR = (const bf16_t*)(F.ws + WS_QR); const bf16_t* KR = (const bf16_t*)(F.ws + WS_KR); const bf16_t* VR = (const bf16_t*)(F.ws + WS_VR);
    __syncthreads();
    load_tile<128, false>(QIMG, (const char*)(QR + (size_t)R0 * 1024 + h * 128), 2048, tid);
    load_tile<128, false>(KIMG, (const char*)(KR + (size_t)R0 * 1024 + h * 128), 2048, tid);
    load_tile<128, false>(VIMG, (const char*)(VR + (size_t)R0 * 1024 + h * 128), 2048, tid);
    if (c > 0) load_tile<128, false>(SIMG, (const char*)((const bf16_t*)(F.ws + WS_SP) + ((size_t)bh * NCH + c) * 16384), 256, tid);
    __syncthreads();
    f32x16 acc[2] = {zero16(), zero16()};
    bf16x8 qf[8];
#pragma unroll
    for (int s = 0; s < 8; ++s) qf[s] = row_frag(QIMG, 32 * it, lane, s);
    if (c > 0) {
#pragma unroll
        for (int s = 0; s < 8; ++s)
#pragma unroll
            for (int e2 = 0; e2 < 2; ++e2) acc[e2] = MFMA32(qf[s], tr_frag(SIMG, 16 * s, 32 * (2 * eh + e2), lane), acc[e2]);
    }
    for (int jt = 0; jt <= it; ++jt) {
        f32x16 X = zero16();
#pragma unroll
        for (int s = 0; s < 8; ++s) X = MFMA32(row_frag(KIMG, 32 * jt, lane, s), qf[s], X);
        if (jt == it) {
#pragma unroll
            for (int r = 0; r < 16; ++r) X[r] = (crow(r, hh) > (lane & 31)) ? 0.f : X[r];
        }
#pragma unroll
        for (int s2 = 0; s2 < 2; ++s2) {
            const u32x4 pw = {cvtpk(X[8 * s2 + 0], X[8 * s2 + 1]), cvtpk(X[8 * s2 + 2], X[8 * s2 + 3]), cvtpk(X[8 * s2 + 4], X[8 * s2 + 5]), cvtpk(X[8 * s2 + 6], X[8 * s2 + 7])};
            const bf16x8 xs = __builtin_bit_cast(bf16x8, pw);
#pragma unroll
            for (int e2 = 0; e2 < 2; ++e2) acc[e2] = MFMA32(xs, tr_frag_perm(VIMG, 32 * jt + 16 * s2, 32 * (2 * eh + e2), lane), acc[e2]);
        }
    }
    __syncthreads();
#pragma unroll
    for (int e2 = 0; e2 < 2; ++e2)
#pragma unroll
        for (int r = 0; r < 16; ++r) OUT[(32 * it + crow(r, hh)) * 129 + 32 * (2 * eh + e2) + (lane & 31)] = acc[e2][r];
    __syncthreads();
    {
        const int i = tid >> 2, qd = tid & 3; float v[32]; float s = 0.f;
#pragma unroll
        for (int e = 0; e < 32; ++e) { v[e] = OUT[i * 129 + 32 * qd + e]; s += v[e]; }
        s += __shfl_xor(s, 1); s += __shfl_xor(s, 2);
        const float mu = s * (1.f / 128); float q = 0.f;
#pragma unroll
        for (int e = 0; e < 32; ++e) { v[e] -= mu; q += v[e] * v[e]; }
        q += __shfl_xor(q, 1); q += __shfl_xor(q, 2);
        const float rs = 1.0f / sqrtf(q * (1.f / 128) + EPS);
        const bf16_t* GR = (const bf16_t*)(F.ws + WS_GR) + (size_t)(R0 + i) * 1024 + h * 128 + 32 * qd; bf16_t* ACT = (bf16_t*)(F.ws + WS_ACT) + (size_t)(R0 + i) * DM + h * 128 + 32 * qd;
        const float* rg = F.ret_g + h * 128 + 32 * qd;
#pragma unroll
        for (int e8 = 0; e8 < 4; ++e8) {
            const u32x4 gw = *(const u32x4*)(GR + 8 * e8); const f32x4 g0 = *(const f32x4*)(rg + 8 * e8), g1 = *(const f32x4*)(rg + 8 * e8 + 4);
            const float o0 = v[8 * e8 + 0] * rs * g0[0] * bflo(gw.x), o1 = v[8 * e8 + 1] * rs * g0[1] * bfhi(gw.x), o2 = v[8 * e8 + 2] * rs * g0[2] * bflo(gw.y), o3 = v[8 * e8 + 3] * rs * g0[3] * bfhi(gw.y);
            const float o4 = v[8 * e8 + 4] * rs * g1[0] * bflo(gw.z), o5 = v[8 * e8 + 5] * rs * g1[1] * bfhi(gw.z), o6 = v[8 * e8 + 6] * rs * g1[2] * bflo(gw.w), o7 = v[8 * e8 + 7] * rs * g1[3] * bfhi(gw.w);
            *(u32x4*)(ACT + 8 * e8) = (u32x4){cvtpk(o0, o1), cvtpk(o2, o3), cvtpk(o4, o5), cvtpk(o6, o7)};
        }
    }
    __syncthreads();
}

DI void p5_sample_outproj(Frame& F) {
    LAS float* xs = (LAS float*)F.lds;
    const float* ACTS = (const float*)(F.ws + WS_ACTS);
    for (int i = F.tid; i < DB * DM / 4; i += NTHR) ((LAS f32x4*)xs)[i] = ((const f32x4*)ACTS)[i];
    __syncthreads();
    const bf16_t* WOT = (const bf16_t*)(F.ws + WS_WOT);
    const int gw = F.bid * NWAVES + F.wave, NGW = F.G * NWAVES, lane = F.lane;
    for (int n = gw; n < DM; n += NGW) {
        asm volatile("" ::: "memory");
        const u32x4* wrow = (const u32x4*)(WOT + (size_t)n * DM);
        float acc[8];
#pragma unroll
        for (int j = 0; j < 8; ++j) acc[j] = 0.f;
#pragma unroll
        for (int i = 0; i < 4; ++i) {
            const u32x4 w = wrow[lane + 64 * i];
            const float w0 = bflo(w.x), w1 = bfhi(w.x), w2 = bflo(w.y), w3 = bfhi(w.y), w4 = bflo(w.z), w5 = bfhi(w.z), w6 = bflo(w.w), w7 = bfhi(w.w);
#pragma unroll
            for (int j = 0; j < 8; ++j) {
                const LAS f32x4* xp = (const LAS f32x4*)(xs + j * DM + 8 * (lane + 64 * i));
                const f32x4 a = xp[0], b = xp[1];
                acc[j] += (a[0] * w0 + a[1] * w1) + (a[2] * w2 + a[3] * w3) + (b[0] * w4 + b[1] * w5) + (b[2] * w6 + b[3] * w7);
            }
        }
#pragma unroll
        for (int j = 0; j < 8; ++j) acc[j] = wave_sum(acc[j]);
        float r = acc[0];
#pragma unroll
        for (int j = 1; j < 8; ++j) r = (lane == j) ? acc[j] : r;
        if (lane < 8) ((float*)(F.ws + WS_HPS))[(size_t)lane * DM + n] = F.xs[(size_t)lane * DM + n] + r;
    }
    __syncthreads();
}

DI void p6_final_norm(Frame& F) {
    const int gw = F.bid * NWAVES + F.wave, NGW = F.G * NWAVES, lane = F.lane;
    const float* PART = (const float*)(F.ws + WS_PART); const float* HP = (const float*)(F.ws + WS_HP);
    for (int m = gw; m < MP; m += 2 * NGW) {
        const int m2 = m + NGW;
        float s0 = (lane < 32) ? PART[(size_t)m * 32 + lane] : 0.f, s1 = (lane < 32) ? PART[(size_t)m2 * 32 + lane] : 0.f;
        const f32x4* h0 = (const f32x4*)(HP + (size_t)m * DM); const f32x4* h1 = (const f32x4*)(HP + (size_t)m2 * DM); f32x4 v0[8], v1[8];
#pragma unroll
        for (int j = 0; j < 8; ++j) { v0[j] = h0[lane + 64 * j]; v1[j] = h1[lane + 64 * j]; }
        s0 = wave_sum(s0); s1 = wave_sum(s1);
        const float r0 = 1.0f / sqrtf(s0 * (1.f / DM) + EPS), r1 = 1.0f / sqrtf(s1 * (1.f / DM) + EPS);
        f32x4* y0 = (f32x4*)(F.out + O_Y + (size_t)m * DM); f32x4* y1 = (f32x4*)(F.out + O_Y + (size_t)m2 * DM);
#pragma unroll
        for (int j = 0; j < 8; ++j) { const f32x4 gv = ((const f32x4*)F.fin_g)[lane + 64 * j]; y0[lane + 64 * j] = v0[j] * r0 * gv; y1[lane + 64 * j] = v1[j] * r1 * gv; }
    }
    if (F.bid == F.G - 1) rms_row<true>((const float*)(F.ws + WS_HPS) + (size_t)F.wave * DM, F.fin_g, F.out + O_YS + (size_t)F.wave * DM, lane);
}

constexpr int NPHASE = 7;
struct Args { const void* in[12]; float* out; unsigned char* ws; int ph_lo, ph_hi, sub, pad; };
__global__ void __launch_bounds__(NTHR, 2) hymba_fwd(Args args) {
    extern __shared__ __attribute__((aligned(16))) unsigned char lds_raw[];
    Frame F;
    F.lds = (LAS unsigned char*)lds_raw; F.MISC = (volatile LAS unsigned*)(F.lds + MISC_OFF);
    F.tid = threadIdx.x; F.lane = F.tid & 63; F.wave = __builtin_amdgcn_readfirstlane(F.tid >> 6); F.G = gridDim.x; F.bid = blockIdx.x;
    F.x = (const float*)args.in[0]; F.xs = (const float*)args.in[1]; F.cache_k = (const float*)args.in[2]; F.cache_v = (const float*)args.in[3]; F.cache_ki = (const float*)args.in[4];
    F.state = (const float*)args.in[5]; F.ptab = (const int*)args.in[6]; F.norm_g = (const float*)args.in[7]; F.w_in = (const float*)args.in[8]; F.ret_g = (const float*)args.in[9];
    F.w_out = (const float*)args.in[10]; F.fin_g = (const float*)args.in[11]; F.out = args.out; F.ws = args.ws; F.ctl = (unsigned*)(args.ws + WS_CTL);
    for (int u = F.tid; u < (LDS_BYTES - RING_BYTES) / 4; u += NTHR) ((LAS unsigned*)(F.lds + RING_BYTES))[u] = 0u;
    __syncthreads();
    const int lo = args.ph_lo, hi = args.ph_hi;
    const bool use_bar = (hi - lo) > 1;
    XcdBarrier bar; bar.bar = F.ctl + CW_BAR; bar.x = 0; bar.st = nullptr;
    if (use_bar) bar = xcd_barrier_post(F.ctl + CW_BAR, F.MISC + 8);
#ifndef PHASE_MASK
#define PHASE_MASK 0x7f
#endif
#define IN(k) (((PHASE_MASK >> (k)) & 1) && lo <= (k) && (k) < hi)
#define SEAM(k) do { if (IN(k) && IN((k) + 1)) xcd_barrier(bar); } while (0)
    const int g = F.bid;
    if (IN(0)) { p0_prologue(F); SEAM(0); }
    if (IN(1)) {
        p1_sample_gemv(F);
        pg8::Gemm gm{(const bf16_t*)(F.ws + WS_XN), (const bf16_t*)(F.ws + WS_WT), MP, DINP, DM}; pg8::StaticOrder S; S.init(MP, DINP, F.G, g);
        EpiInProj E{(bf16_t*)(F.ws + WS_QR), (bf16_t*)(F.ws + WS_KR), (bf16_t*)(F.ws + WS_VR), (bf16_t*)(F.ws + WS_GR), (bf16_t*)(F.ws + WS_QA), (bf16_t*)(F.ws + WS_KA), (bf16_t*)(F.ws + WS_VA),
                    (bf16_t*)(F.ws + WS_GA), (bf16_t*)(F.ws + WS_QI), (bf16_t*)(F.ws + WS_KI), (float*)(F.ws + WS_WI), F.out + O_NK, F.out + O_NV, F.out + O_NKI, (const float*)(F.ws + WS_CS)};
        VM_WAIT(); __syncthreads();
        if (F.tid == 0) { __builtin_amdgcn_fence(__ATOMIC_RELEASE, "agent"); VM_WAIT(); (void)xb_add(F.ctl + CW_ZS, 1u); }
        pg8::gemm_phase<EpiInProj, pg8::StaticOrder, true, true>(F.lds, gm, S, E);
        if (g >= 96) {
            if (F.tid == 0) { unsigned sp = 0; while (xb_ld(F.ctl + CW_ZS) < (unsigned)F.G) { __builtin_amdgcn_s_sleep(2); if (++sp > (1u << 22)) break; }
                __builtin_amdgcn_fence(__ATOMIC_ACQUIRE, "agent"); VM_WAIT(); }
            __syncthreads();
            for (int tk = g - 96; tk < 256; tk += 160) p2_sample_scores(F, tk);
            if (g >= 192) p2_sample_retention(F, (g - 192) >> 3, (g - 192) & 7);
        }
        SEAM(1);
    }
    if (IN(2)) {
        if (g == 64) { const float* ZS = (const float*)(F.ws + WS_ZS);
            for (int i = F.tid; i < DB * 256; i += NTHR) { const int b = i >> 8, k = i & 255; F.out[O_NKS + i] = ZS[(size_t)b * DIN + C_KA + k]; F.out[O_NVS + i] = ZS[(size_t)b * DIN + C_VA + k]; }
            for (int i = F.tid; i < DB * 128; i += NTHR) { const int b = i >> 7, k = i & 127; F.out[O_NKIS + i] = ZS[(size_t)b * DIN + C_KI + k]; } }
        const int sub = args.sub;
        if (sub & 4) for (int u = g; u < 512; u += F.G) p2_retA_unit(F, u >> 4, u & 15);
        if (sub & 56) for (int bq = 0; bq < NB; ++bq) { const int j = (bq & 1) ? (255 - (g & 255)) : (g & 255); if (g < 256) p2_indexer_unit(F, bq, j, (sub & 8) ? 7 : ((sub & 16) ? 1 : 2)); }
        SEAM(2);
    }
    if (IN(3)) {
        p3_scan(F);
        SEAM(3);
    }
    if (IN(4)) {
        if ((args.sub & 16) && g < DB) p3_sample_attend(F, g);
        if ((args.sub & 1) && g >= DB) for (int u = g - DB; u < 512; u += F.G - DB) p4_retB_unit(F, u >> 4, u & 15);
        if ((args.sub & 14) && g < 256) { const int b = g >> 6, c2 = (g >> 5) & 1, jj = g & 31; const int md = (args.sub & 2) ? 7 : ((args.sub & 4) ? 1 : 2); p4_attn_unit32(F, b, c2, jj, md); p4_attn_unit32(F, b, c2, 63 - jj, md); }
        SEAM(4);
    }
    if (IN(5)) {
        p5_sample_outproj(F);
        pg8::Gemm gm{(const bf16_t*)(F.ws + WS_ACT), (const bf16_t*)(F.ws + WS_WOT), MP, DM, DM}; pg8::StaticOrder S; S.init(MP, DM, F.G, g);
        EpiOutProj E{F.x, (float*)(F.ws + WS_HP), (float*)(F.ws + WS_PART)};
        pg8::gemm_phase<EpiOutProj, pg8::StaticOrder, false, true>(F.lds, gm, S, E);
        SEAM(5);
    }
    if (IN(6)) p6_final_norm(F);
#undef IN
#undef SEAM
}

extern "C" void kernel_launch(void* const* d_in, const int* in_sizes, int n_in, void* d_out, int out_size, void* d_ws, size_t ws_size, hipStream_t stream) {
    static int grid = 0;
    if (grid == 0) {
        if (n_in != 12 || ws_size < WS_END) { fprintf(stderr, "kernel_launch: unexpected inputs (n_in %d, ws %zu)\n", n_in, ws_size); grid = -1; return; }
        if (hipFuncSetAttribute((const void*)hymba_fwd, hipFuncAttributeMaxDynamicSharedMemorySize, LDS_BYTES) != hipSuccess) { fprintf(stderr, "kernel_launch: hipFuncSetAttribute failed\n"); grid = -1; return; }
        int dev = 0, cus = 0, per_cu = 0;
        hipGetDevice(&dev); hipDeviceGetAttribute(&cus, hipDeviceAttributeMultiprocessorCount, dev);
        hipOccupancyMaxActiveBlocksPerMultiprocessor(&per_cu, (const void*)hymba_fwd, NTHR, LDS_BYTES);
        (void)hipGetLastError();
        if (per_cu < 1) fprintf(stderr, "kernel_launch: occupancy query reports %d blocks per CU\n", per_cu);
        grid = 256;
        if (cus < 256) fprintf(stderr, "kernel_launch: device has %d CUs; this kernel needs 256 co-resident workgroups\n", cus);
    }
    if (grid < 0) return;
    (void)hipMemsetAsync((char*)d_ws + WS_CTL, 0, CTL_ZERO_BYTES, stream);
    Args a{};
    for (int i = 0; i < 12; ++i) a.in[i] = d_in[i];
    a.out = (float*)d_out; a.ws = (unsigned char*)d_ws; a.sub = 0xff;
    if (MK_N_LAUNCHES == 1) {
        a.ph_lo = 0; a.ph_hi = NPHASE;
        hipLaunchKernelGGL(hymba_fwd, dim3(grid), dim3(NTHR), LDS_BYTES, stream, a);
    } else {
        for (int p = 0; p < NPHASE; ++p) {
            int reps = 1;
#ifdef PROBE_DOUBLE
            if (p == PROBE_DOUBLE) reps = 2;
#endif
            for (int r = 0; r < reps; ++r) { a.ph_lo = p; a.ph_hi = p + 1; a.sub = 0xff;
#ifdef PROBE_SUB
                if (r == 1) a.sub = PROBE_SUB;
#endif
                hipLaunchKernelGGL(hymba_fwd, dim3(grid), dim3(NTHR), LDS_BYTES, stream, a); }
        }
    }
}
```
